# Optimizing an MI355X kernel written in HIP

```python
import jax
import jax.numpy as jnp
from jax import lax
import numpy as np

D_MODEL = 1024
BATCH = 2
SEQ = 8192
DEPTH = 1

GRID_W = 64
CTX_LEN = 256
NA_HEADS = 8
NA_HEAD_DIM = 64
NA_WIDTH = NA_HEADS * NA_HEAD_DIM
NA_KR_MAX = 8
NA_KC = 16
HG_HEADS = 4
HG_DK = 128
HG_DV = 128
HG_K_WIDTH = HG_HEADS * HG_DK
HG_V_WIDTH = HG_HEADS * HG_DV
HG_CHUNK = 64
MIX_WIDTH = NA_WIDTH + HG_V_WIDTH
IN_SPLITS = (NA_WIDTH, NA_WIDTH, NA_WIDTH, HG_K_WIDTH, HG_K_WIDTH, HG_K_WIDTH, HG_V_WIDTH, HG_V_WIDTH)
IN_WIDTH = sum(IN_SPLITS)
D_FF = -(-8 * D_MODEL // (3 * 256)) * 256
N_MOD = 6
EPS = 1e-6

kernel_name = 'hybrid_natten_hgrn2_dit_layer'


def rmsnorm(x, w):
    xf = x.astype(jnp.float32)
    y = xf * lax.rsqrt(jnp.mean(xf * xf, axis=-1, keepdims=True) + EPS)
    return (y * w.astype(jnp.float32)).astype(x.dtype)


def split_proj(p):
    offsets = tuple(int(o) for o in np.cumsum(IN_SPLITS)[:-1])
    return jnp.split(p, offsets, axis=-1)


def to_heads(t, n_heads):
    return t.reshape(t.shape[0], t.shape[1], n_heads, -1)


def rev(t):
    return jnp.flip(t, axis=1)


def swiglu(h, w_ffn_in, w_ffn_out):
    gate, up = jnp.split(h @ w_ffn_in, 2, axis=-1)
    return (jax.nn.silu(gate) * up) @ w_ffn_out


def neighbourhood_attention(q, k, v, k_ctx, v_ctx, rpb):
    B, T = q.shape[0], q.shape[1]
    rows = T // GRID_W
    kr = min(NA_KR_MAX, rows)
    n_win = kr * NA_KC
    grid = lambda t: t.reshape(B, rows, GRID_W, NA_HEADS, NA_HEAD_DIM)
    qg = grid(q * NA_HEAD_DIM ** -0.5)
    kg, vg = grid(k), grid(v)
    cols = np.arange(GRID_W)
    col_idx = np.clip(cols - NA_KC // 2, 0, GRID_W - NA_KC)[:, None] + np.arange(NA_KC)[None, :]
    dc_idx = col_idx - cols[:, None] + (NA_KC - 1)

    def row_block(args):
        r, q_r = args
        r0 = jnp.clip(r - kr // 2, 0, rows - kr)
        k_win = lax.dynamic_slice_in_dim(kg, r0, kr, axis=1)[:, :, col_idx]
        v_win = lax.dynamic_slice_in_dim(vg, r0, kr, axis=1)[:, :, col_idx]
        dr_idx = r0 + jnp.arange(kr) - r + (NA_KR_MAX - 1)
        bias = rpb[:, dr_idx[None, :, None], dc_idx[:, None, :]].astype(jnp.float32)
        s_win = jnp.einsum('bwhd,brwkhd->bhwrk', q_r, k_win).astype(jnp.float32) + bias
        s_ctx = jnp.einsum('bwhd,blhd->bhwl', q_r, k_ctx).astype(jnp.float32)
        s = jnp.concatenate([s_win.reshape(B, NA_HEADS, GRID_W, n_win), s_ctx], axis=-1)
        p = jax.nn.softmax(s, axis=-1).astype(v.dtype)
        p_win = p[..., :n_win].reshape(B, NA_HEADS, GRID_W, kr, NA_KC)
        return (jnp.einsum('bhwrk,brwkhd->bwhd', p_win, v_win)
                + jnp.einsum('bhwl,blhd->bwhd', p[..., n_win:], v_ctx))

    o = lax.map(row_block, (jnp.arange(rows), jnp.moveaxis(qg, 1, 0)))
    return jnp.moveaxis(o, 0, 1).reshape(B, T, NA_WIDTH)


def context_attention(q, k, v):
    B, L = q.shape[0], q.shape[1]
    s = jnp.einsum('blhd,bmhd->bhlm', q * NA_HEAD_DIM ** -0.5, k).astype(jnp.float32)
    p = jax.nn.softmax(s, axis=-1).astype(v.dtype)
    return jnp.einsum('bhlm,bmhd->blhd', p, v).reshape(B, L, NA_WIDTH)


def hgrn2_gates(f_logits, lb):
    f = lb + (1.0 - lb) * jax.nn.sigmoid(f_logits.astype(jnp.float32))
    return to_heads(1.0 - f, HG_HEADS), to_heads(jnp.log(f), HG_HEADS)


def gla_chunk_scan(q, k, v, g, s0):
    B, T = q.shape[0], q.shape[1]
    n_chunks = T // HG_CHUNK
    to_chunks = lambda t: t.reshape(B, n_chunks, HG_CHUNK, HG_HEADS, t.shape[-1]).transpose(1, 0, 3, 2, 4)
    lower_tri = np.tril(np.ones((HG_CHUNK, HG_CHUNK), dtype=bool))

    def step(s, inp):
        qc, kc, vc, gc = inp
        b = jnp.cumsum(gc, axis=2)
        o_inter = jnp.einsum('bhtk,bhkv->bhtv', qc * jnp.exp(b), s)
        diff = jnp.where(lower_tri[:, :, None], b[:, :, :, None, :] - b[:, :, None, :, :], -jnp.inf)
        a = jnp.einsum('bhtk,bhsk,bhtsk->bhts', qc, kc, jnp.exp(diff))
        o = o_inter + jnp.einsum('bhts,bhsv->bhtv', a, vc)
        b_last = b[:, :, -1]
        s_new = (jnp.exp(b_last)[..., None] * s
                 + jnp.einsum('bhsk,bhsv->bhkv', kc * jnp.exp(b_last[:, :, None, :] - b), vc))
        return s_new, o

    _, o = lax.scan(step, s0, (to_chunks(q), to_chunks(k), to_chunks(v), to_chunks(g)))
    return o.transpose(1, 0, 3, 2, 4).reshape(B, T, HG_HEADS, HG_DV)


def gla_final_state(k, v, g):
    b = jnp.cumsum(g, axis=1)
    w = jnp.exp(b[:, -1:] - b)
    return jnp.einsum('blhk,blhv->bhkv', k * w, v)


def gated_group_norm(o, gate, w):
    o = o * lax.rsqrt(jnp.mean(o * o, axis=-1, keepdims=True) + EPS) * w.astype(jnp.float32)
    o = o * jax.nn.silu(to_heads(gate, HG_HEADS).astype(jnp.float32))
    return o.reshape(o.shape[0], o.shape[1], HG_V_WIDTH)


def hybrid_mixer(h, h_c, w_in, w_out, rpb, lb, hg_norm_w, with_ctx_out):
    f32 = jnp.float32
    B = h.shape[0]
    na_q, na_k, na_v, hg_q, hg_ff, hg_fb, hg_i, hg_g = split_proj(h @ w_in)
    na_qc, na_kc, na_vc, hg_qc, hg_ffc, hg_fbc, hg_ic, hg_gc = split_proj(h_c @ w_in)
    k_c_na, v_c_na = to_heads(na_kc, NA_HEADS), to_heads(na_vc, NA_HEADS)
    y_na = neighbourhood_attention(to_heads(na_q, NA_HEADS), to_heads(na_k, NA_HEADS),
                                   to_heads(na_v, NA_HEADS), k_c_na, v_c_na, rpb)
    q = to_heads(jax.nn.silu(hg_q), HG_HEADS).astype(f32)
    v = to_heads(hg_i, HG_HEADS).astype(f32)
    k_fw, g_fw = hgrn2_gates(hg_ff, lb[0])
    k_bw, g_bw = hgrn2_gates(hg_fb, lb[1])
    v_c = to_heads(hg_ic, HG_HEADS).astype(f32)
    k_cfw, g_cfw = hgrn2_gates(hg_ffc, lb[0])
    k_cbw, g_cbw = hgrn2_gates(hg_fbc, lb[1])
    s_fw = gla_final_state(k_cfw, v_c, g_cfw)
    s_bw = gla_final_state(rev(k_cbw), rev(v_c), rev(g_cbw))
    o_hg = (gla_chunk_scan(q, k_fw, v, g_fw, s_fw)
            + rev(gla_chunk_scan(rev(q), rev(k_bw), rev(v), rev(g_bw), s_bw)))
    y_hg = gated_group_norm(o_hg, hg_g, hg_norm_w).astype(h.dtype)
    y = jnp.concatenate([y_na, y_hg], axis=-1) @ w_out
    if not with_ctx_out:
        return y, None
    y_c_na = context_attention(to_heads(na_qc, NA_HEADS), k_c_na, v_c_na)
    q_c = to_heads(jax.nn.silu(hg_qc), HG_HEADS).astype(f32)
    zero_state = jnp.zeros((B, HG_HEADS, HG_DK, HG_DV), f32)
    o_c = (gla_chunk_scan(q_c, k_cfw, v_c, g_cfw, zero_state)
           + rev(gla_chunk_scan(rev(q_c), rev(k_cbw), rev(v_c), rev(g_cbw), zero_state)))
    y_c_hg = gated_group_norm(o_c, hg_gc, hg_norm_w).astype(h.dtype)
    y_c = jnp.concatenate([y_c_na, y_c_hg], axis=-1) @ w_out
    return y, y_c


def trunk_layer(x, ctx, c, c_ctx, w_ada, b_ada, n_mix_pre, n_mix_post, n_ffn_pre, n_ffn_post,
                w_in, rpb, lb, hg_norm_w, w_out, w_ffn_in, w_ffn_out, last):
    sh_m, sc_m, gt_m, sh_f, sc_f, gt_f = jnp.split((jax.nn.silu(c) @ w_ada + b_ada)[:, None, :], N_MOD, axis=-1)
    csh_m, csc_m, cgt_m, csh_f, csc_f, cgt_f = jnp.split(jax.nn.silu(c_ctx) @ w_ada + b_ada, N_MOD, axis=-1)
    h = rmsnorm(x, n_mix_pre) * (1.0 + sc_m) + sh_m
    h_c = rmsnorm(ctx, n_mix_pre) * (1.0 + csc_m) + csh_m
    y, y_c = hybrid_mixer(h, h_c, w_in, w_out, rpb, lb, hg_norm_w, not last)
    x = x + gt_m * rmsnorm(y, n_mix_post)
    h = rmsnorm(x, n_ffn_pre) * (1.0 + sc_f) + sh_f
    x = x + gt_f * rmsnorm(swiglu(h, w_ffn_in, w_ffn_out), n_ffn_post)
    if last:
        return x, ctx
    ctx = ctx + cgt_m * rmsnorm(y_c, n_mix_post)
    h_c = rmsnorm(ctx, n_ffn_pre) * (1.0 + csc_f) + csh_f
    ctx = ctx + cgt_f * rmsnorm(swiglu(h_c, w_ffn_in, w_ffn_out), n_ffn_post)
    return x, ctx


def setup_inputs(seed: int = 0) -> dict:
    key = jax.random.key(seed)
    ks = jax.random.split(key, 17)
    nrm = lambda k, shape, scale: scale * jax.random.normal(k, shape, jnp.float32)
    gain = lambda k, n: 1.0 + nrm(k, (DEPTH, n), 0.01)
    return {
        'x': nrm(ks[0], (BATCH, SEQ, D_MODEL), 1.0),
        'c': nrm(ks[1], (BATCH, D_MODEL), 1.0),
        'ctx': nrm(ks[2], (BATCH, CTX_LEN, D_MODEL), 1.0),
        'c_ctx': nrm(ks[3], (D_MODEL,), 1.0),
        'w_ada': nrm(ks[4], (DEPTH, D_MODEL, N_MOD * D_MODEL), 0.5 * D_MODEL ** -0.5),
        'b_ada': nrm(ks[5], (DEPTH, N_MOD * D_MODEL), 0.01),
        'norm_mix_pre': gain(ks[6], D_MODEL),
        'norm_mix_post': gain(ks[7], D_MODEL),
        'norm_ffn_pre': gain(ks[8], D_MODEL),
        'norm_ffn_post': gain(ks[9], D_MODEL),
        'w_in': nrm(ks[10], (DEPTH, D_MODEL, IN_WIDTH), D_MODEL ** -0.5),
        'na_rpb': nrm(ks[11], (DEPTH, NA_HEADS, 2 * NA_KR_MAX - 1, 2 * NA_KC - 1), 0.1),
        'hg_lb_logits': nrm(ks[12], (DEPTH + 1, 2, HG_K_WIDTH), 0.5),
        'hg_norm_w': gain(ks[13], HG_DV),
        'w_out': nrm(ks[14], (DEPTH, MIX_WIDTH, D_MODEL), MIX_WIDTH ** -0.5),
        'w_ffn_in': nrm(ks[15], (DEPTH, D_MODEL, 2 * D_FF), D_MODEL ** -0.5),
        'w_ffn_out': nrm(ks[16], (DEPTH, D_FF, D_MODEL), D_FF ** -0.5),
    }


def reference(x, c, ctx, c_ctx, w_ada, b_ada, norm_mix_pre, norm_mix_post, norm_ffn_pre, norm_ffn_post,
              w_in, na_rpb, hg_lb_logits, hg_norm_w, w_out, w_ffn_in, w_ffn_out):
    lower_bounds = jnp.cumsum(jax.nn.softmax(hg_lb_logits.astype(jnp.float32), axis=0), axis=0)
    for l in range(DEPTH):
        x, ctx = trunk_layer(x, ctx, c, c_ctx, w_ada[l], b_ada[l], norm_mix_pre[l], norm_mix_post[l],
                             norm_ffn_pre[l], norm_ffn_post[l], w_in[l], na_rpb[l], lower_bounds[l],
                             hg_norm_w[l], w_out[l], w_ffn_in[l], w_ffn_out[l], l == DEPTH - 1)
    return x
```

```cpp
#include <hip/hip_runtime.h>
#include <hip/hip_cooperative_groups.h>
#include <cstdio>
#include <cstdint>
namespace cg = cooperative_groups;
namespace pg8 {
#define PG8_LAS __attribute__((address_space(3)))
typedef unsigned short bf16_t;
typedef short bf16x8 __attribute__((ext_vector_type(8)));
typedef float f32x4 __attribute__((ext_vector_type(4)));
typedef unsigned u32x4 __attribute__((ext_vector_type(4)));
constexpr int BM = 256, BK = 64, HALF = 128, HTB = HALF * BK * 2  , STAGE_BYTES = 8 * HTB, NXCD = 8, WGM = 8;

__host__ __device__ __forceinline__ int lds_byte(int r, int c) { const int st = (r >> 4) * 2 + (c >> 5), rr = r & 15, cc = c & 31, ob = rr * 64 + cc * 2; return st * 1024 + (ob ^ (((ob >> 9) & 1) << 5)); }
__host__ __device__ __forceinline__ void stage_rc(int b, int& R, int& C) { const int st = b / 1024, sb = b % 1024, swz = sb ^ (((sb >> 9) & 1) << 5); R = (st >> 1) * 16 + swz / 64; C = (st & 1) * 32 + (swz % 64) / 2; }
__host__ __device__ __forceinline__ int perm32(int rho) { const int n = rho >> 4, i = rho & 15; return 8 * (i >> 2) + 4 * n + (i & 3); }

struct Unit { int pm, pn; };
struct Gemm { const bf16_t* A; const bf16_t* Bt; int M, N, K; };

struct StaticOrder {
    int nM, nN, nwg, G, c;
    __host__ __device__ void init(int M, int N, int G_, int c_) { nM = M / BM; nN = N / BM; nwg = nM * nN; G = G_; c = c_; }
    __host__ __device__ bool next(int i, Unit& u) const {
        const long L = (long)i * G + c; if (L >= nwg) return false;
        int wgid = (int)L; { const int q = nwg / NXCD, r = nwg % NXCD, xcd = wgid % NXCD, off = wgid / NXCD; wgid = (xcd < r ? xcd * (q + 1) : r * (q + 1) + (xcd - r) * q) + off; }
        const int nig = WGM * nN, gid = wgid / nig, fm = gid * WGM, gsz = (nM - fm) < WGM ? (nM - fm) : WGM;
        u.pm = fm + ((wgid % nig) % gsz); u.pn = (wgid % nig) / gsz; return true;
    }
    __device__ __forceinline__ void a_ready(const Unit&) const {}
    __device__ __forceinline__ void done(const Unit&) const {}
};
__device__ __forceinline__ unsigned cvt_pk_bf16(float lo, float hi) { unsigned r; asm volatile("v_cvt_pk_bf16_f32 %0, %1, %2" : "=v"(r) : "v"(lo), "v"(hi)); return r; }
template <class Epi, class Sched, bool ALIGN_EPI = false, bool SP2 = false>
__device__ __forceinline__ void gemm_phase(PG8_LAS unsigned char* lds, const Gemm g, const Sched& S, const Epi& E) {
    const int tid = threadIdx.x, wid = __builtin_amdgcn_readfirstlane(tid >> 6), lane = tid & 63, wr = wid >> 2, wc = wid & 3, fr = lane & 15, fq = lane >> 4;
    const int K = g.K, nt = K / BK;
    unsigned voffA[2], voffB[2];
#pragma unroll
    for (int i = 0; i < 2; ++i) { int R, C; stage_rc(tid * 16 + i * 8192, R, C); const int Rb = Epi::PERM ? ((R & ~31) + perm32(R & 31)) : R;
        voffA[i] = (unsigned)(R * K + C) * 2u; voffB[i] = (unsigned)(Rb * K + C) * 2u; }
    const size_t kstep = (size_t)(BK * 2);
    const size_t hstep = (size_t)HALF * K * 2;
    const size_t tstep = 2 * hstep;
    const unsigned ldsw = (unsigned)wid * 1024u;
    const int aoff = lds_byte(wr * 64 + fr, fq * 8), boff = lds_byte(wc * 32 + fr, fq * 8);
#define PG8_SA(b, h) (((b) * 2 + (h)) * HTB)
#define PG8_SB(b, h) ((4 + (b) * 2 + (h)) * HTB)
#define PG8_STAGE(bufoff, gbase, voff) do { _Pragma("unroll") for (int _i = 0; _i < 2; ++_i) \
        __builtin_amdgcn_global_load_lds((const unsigned*)((const char*)(gbase) + (voff)[_i]), (PG8_LAS unsigned*)(lds + (bufoff) + ldsw + _i * 8192), 16, 0, 0); } while (0)
#define PG8_LDA(dst, b, h) do { _Pragma("unroll") for (int m = 0; m < 4; ++m) _Pragma("unroll") for (int k = 0; k < 2; ++k) dst[m][k] = *(const PG8_LAS bf16x8*)(lds + PG8_SA(b, h) + aoff + m * 2048 + k * 1024); } while (0)
#define PG8_LDB(dst, b, h) do { _Pragma("unroll") for (int n = 0; n < 2; ++n) _Pragma("unroll") for (int k = 0; k < 2; ++k) dst[n][k] = *(const PG8_LAS bf16x8*)(lds + PG8_SB(b, h) + boff + n * 2048 + k * 1024); } while (0)
#define PG8_MMA(ai, bj, At, Bt) do { __builtin_amdgcn_s_setprio(1); _Pragma("unroll") for (int m = 0; m < 4; ++m) _Pragma("unroll") for (int n = 0; n < 2; ++n) _Pragma("unroll") for (int k = 0; k < 2; ++k) \
        acc[ai][bj][m][n] = __builtin_amdgcn_mfma_f32_16x16x32_bf16(Bt[n][k], At[m][k], acc[ai][bj][m][n], 0, 0, 0); __builtin_amdgcn_s_setprio(0); } while (0)
#define PG8_WAIT_V(n) asm volatile("s_waitcnt vmcnt(" #n ")" ::: "memory")
#define PG8_WAIT_L(n) asm volatile("s_waitcnt lgkmcnt(" #n ")" ::: "memory")
#define PG8_BAR __builtin_amdgcn_s_barrier()
#define PG8_SCHED __builtin_amdgcn_sched_barrier(0)
    Unit cur, nxt; int ui = 0;
    if (!S.next(0, cur)) return;
    f32x4 acc[2][2][4][2];
#pragma unroll
    for (int a = 0; a < 2; ++a)
#pragma unroll
        for (int b = 0; b < 2; ++b)
#pragma unroll
            for (int m = 0; m < 4; ++m)
#pragma unroll
                for (int n = 0; n < 2; ++n) acc[a][b][m][n] = (f32x4){0.f, 0.f, 0.f, 0.f};
    bf16x8 At[4][2], B0[2][2], B1[2][2];
    const char* cA = (const char*)g.A + (size_t)cur.pm * tstep; const char* cB = (const char*)g.Bt + (size_t)cur.pn * tstep;
    S.a_ready(cur);
    if constexpr (SP2) {
        PG8_STAGE(PG8_SB(0, 0), cB, voffB); PG8_STAGE(PG8_SB(0, 1), cB + hstep, voffB); PG8_STAGE(PG8_SA(0, 0), cA, voffA); PG8_STAGE(PG8_SA(0, 1), cA + hstep, voffA);
        if (wr == 1) PG8_BAR;
        PG8_WAIT_V(2); PG8_BAR;
        PG8_STAGE(PG8_SB(1, 0), cB + kstep, voffB); PG8_STAGE(PG8_SA(1, 0), cA + kstep, voffA); PG8_STAGE(PG8_SB(1, 1), cB + hstep + kstep, voffB);
        PG8_WAIT_V(6); PG8_BAR;
    } else {
        PG8_STAGE(PG8_SB(0, 0), cB, voffB); PG8_STAGE(PG8_SA(0, 0), cA, voffA); PG8_STAGE(PG8_SB(0, 1), cB + hstep, voffB); PG8_STAGE(PG8_SA(0, 1), cA + hstep, voffA);
        if (wr == 1) PG8_BAR;
        PG8_WAIT_V(4); PG8_BAR;
        PG8_STAGE(PG8_SB(1, 0), cB + kstep, voffB); PG8_STAGE(PG8_SA(1, 0), cA + kstep, voffA); PG8_STAGE(PG8_SB(1, 1), cB + hstep + kstep, voffB);
        PG8_WAIT_V(6); PG8_BAR;
    }
    for (;;) {
        const bool has_next = S.next(ui + 1, nxt);
        const char* nA = has_next ? (const char*)g.A + (size_t)nxt.pm * tstep : cA; const char* nB = has_next ? (const char*)g.Bt + (size_t)nxt.pn * tstep : cB;
        for (int t = 0; t < nt; t += 2) {
            const bool last = (t == nt - 2);
            const char* a1 = cA + (size_t)(t + 1) * kstep;
            const char* a2 = last ? nA : cA + (size_t)(t + 2) * kstep; const char* b2 = last ? nB : cB + (size_t)(t + 2) * kstep;
            const char* a3 = a2 + kstep; const char* b3 = b2 + kstep;
            if (last && has_next) S.a_ready(nxt);
            if constexpr (SP2) {
            PG8_LDB(B0, 0, 0); PG8_LDB(B1, 0, 1); PG8_SCHED; PG8_LDA(At, 0, 0); PG8_STAGE(PG8_SA(1, 1), a1 + hstep, voffA);
            PG8_WAIT_V(8); PG8_WAIT_L(0); PG8_BAR; PG8_MMA(0, 0, At, B0); PG8_MMA(0, 1, At, B1); PG8_BAR; PG8_SCHED;
            PG8_LDA(At, 0, 1); PG8_STAGE(PG8_SB(0, 0), b2, voffB); PG8_STAGE(PG8_SB(0, 1), b2 + hstep, voffB); PG8_STAGE(PG8_SA(0, 0), a2, voffA);
            PG8_WAIT_V(8); PG8_WAIT_L(0); PG8_BAR; PG8_MMA(1, 0, At, B0); PG8_MMA(1, 1, At, B1); PG8_BAR; PG8_SCHED;
            PG8_LDB(B0, 1, 0); PG8_LDB(B1, 1, 1); PG8_SCHED; PG8_LDA(At, 1, 0); PG8_STAGE(PG8_SA(0, 1), a2 + hstep, voffA);
            PG8_WAIT_V(8); PG8_WAIT_L(0); PG8_BAR; PG8_MMA(0, 0, At, B0); PG8_MMA(0, 1, At, B1); PG8_BAR; PG8_SCHED;
            PG8_LDA(At, 1, 1); PG8_STAGE(PG8_SB(1, 0), b3, voffB); PG8_STAGE(PG8_SB(1, 1), b3 + hstep, voffB); PG8_STAGE(PG8_SA(1, 0), a3, voffA);
            PG8_WAIT_V(8); PG8_WAIT_L(0); PG8_BAR; PG8_MMA(1, 0, At, B0); PG8_MMA(1, 1, At, B1); PG8_BAR; PG8_SCHED;
            } else {
            PG8_LDB(B0, 0, 0); PG8_SCHED; PG8_LDA(At, 0, 0); PG8_STAGE(PG8_SA(1, 1), a1 + hstep, voffA);
            PG8_WAIT_L(8); PG8_BAR; PG8_WAIT_L(0); PG8_MMA(0, 0, At, B0); PG8_BAR; PG8_SCHED;
            PG8_LDB(B1, 0, 1); PG8_STAGE(PG8_SB(0, 0), b2, voffB);
            PG8_BAR; PG8_WAIT_L(0); PG8_MMA(0, 1, At, B1); PG8_BAR;
            PG8_LDA(At, 0, 1); PG8_STAGE(PG8_SA(0, 0), a2, voffA);
            PG8_BAR; PG8_WAIT_L(0); PG8_MMA(1, 0, At, B0); PG8_BAR; PG8_SCHED;
            PG8_STAGE(PG8_SB(0, 1), b2 + hstep, voffB);
            PG8_WAIT_V(6); PG8_BAR; PG8_MMA(1, 1, At, B1); PG8_BAR;
            PG8_LDB(B0, 1, 0); PG8_SCHED; PG8_LDA(At, 1, 0); PG8_STAGE(PG8_SA(0, 1), a2 + hstep, voffA);
            PG8_WAIT_L(8); PG8_BAR; PG8_WAIT_L(0); PG8_MMA(0, 0, At, B0); PG8_BAR; PG8_SCHED;
            PG8_LDB(B1, 1, 1); PG8_STAGE(PG8_SB(1, 0), b3, voffB);
            PG8_BAR; PG8_WAIT_L(0); PG8_MMA(0, 1, At, B1); PG8_BAR;
            PG8_LDA(At, 1, 1); PG8_STAGE(PG8_SA(1, 0), a3, voffA);
            PG8_BAR; PG8_WAIT_L(0); PG8_MMA(1, 0, At, B0); PG8_BAR; PG8_SCHED;
            PG8_STAGE(PG8_SB(1, 1), b3 + hstep, voffB);
            PG8_WAIT_V(6); PG8_BAR; PG8_MMA(1, 1, At, B1); PG8_BAR;
            }
        }
        if constexpr (ALIGN_EPI) { if (wr == 0) PG8_BAR; }
        if constexpr (!Epi::AFTER_DRAIN) { E(acc, cur, wr, wc, fr, fq); S.done(cur); }
        if (!has_next) break;
#pragma unroll
        for (int a = 0; a < 2; ++a)
#pragma unroll
            for (int b = 0; b < 2; ++b)
#pragma unroll
                for (int m = 0; m < 4; ++m)
#pragma unroll
                    for (int n = 0; n < 2; ++n) acc[a][b][m][n] = (f32x4){0.f, 0.f, 0.f, 0.f};
        cur = nxt; cA = nA; cB = nB; ++ui;
        if constexpr (ALIGN_EPI) { if (wr == 1) PG8_BAR; }
    }
    PG8_WAIT_V(0);
    if constexpr (!ALIGN_EPI) { if (wr == 0) PG8_BAR; }
    PG8_BAR;
    if constexpr (Epi::AFTER_DRAIN) { E.fused(acc, cur, wr, wc, fr, fq, lds, wid, lane); S.done(cur); }
#undef PG8_SA
#undef PG8_SB
#undef PG8_STAGE
#undef PG8_LDA
#undef PG8_LDB
#undef PG8_MMA
#undef PG8_WAIT_V
#undef PG8_WAIT_L
#undef PG8_BAR
#undef PG8_SCHED
}
}

#define LAS __attribute__((address_space(3)))
typedef unsigned short bf16_t;
typedef short bf16x8 __attribute__((ext_vector_type(8)));
typedef float f32x4 __attribute__((ext_vector_type(4)));
typedef float f32x2 __attribute__((ext_vector_type(2)));
typedef unsigned u32x4 __attribute__((ext_vector_type(4)));
typedef unsigned u32x2 __attribute__((ext_vector_type(2)));

constexpr int NB = 2, T = 8192, D = 1024, LC = 256;
constexpr int MROWS = NB * T, MCTX = NB * LC, MTOT = MROWS + MCTX;
constexpr int NIN = 4096, DFF = 2816, NFF2 = 5632, PBP = 3072;
constexpr float EPS = 1e-6f;
constexpr int NTHREADS = 512;
constexpr int LDS_BYTES = 147456;
constexpr int N_LAT_ITEMS = 2048, N_ITEMS = 2112;

constexpr size_t WS_WT1 = 0;
constexpr size_t WS_WT2 = WS_WT1 + (size_t)NIN * D * 2;
constexpr size_t WS_WT3 = WS_WT2 + (size_t)D * D * 2;
constexpr size_t WS_WT4 = WS_WT3 + (size_t)NFF2 * D * 2;
constexpr size_t WS_MOD = WS_WT4 + (size_t)D * DFF * 2;
constexpr size_t WS_LB = WS_MOD + 3 * 6144 * 4;
constexpr size_t WS_DEC = WS_LB + 4096;
constexpr size_t WS_UCTX = WS_DEC + (size_t)N_ITEMS * 128 * 4;
constexpr size_t WS_HN = WS_UCTX + (size_t)64 * 32768;
constexpr size_t WS_PB = WS_HN + (size_t)MTOT * D * 2;
constexpr size_t WS_G = WS_PB + (size_t)MTOT * PBP * 2;
constexpr size_t WS_END = WS_G + (size_t)MTOT * 1024 * 4;
static_assert(WS_END <= 268435456, "d_ws map");

struct Params { const float* in[17]; float* out; unsigned char* ws; int ph_lo, ph_hi; };

__device__ __forceinline__ unsigned f2bf(float f) { unsigned u = __builtin_bit_cast(unsigned, f); return (u + 0x7fffu + ((u >> 16) & 1u)) >> 16; }
__device__ __forceinline__ float bf2f(unsigned h) { return __builtin_bit_cast(float, h << 16); }
__device__ __forceinline__ unsigned pk2(float lo, float hi) { return f2bf(lo) | (f2bf(hi) << 16); }
__device__ __forceinline__ float silu_f(float x) { return x / (1.f + __expf(-x)); }
__device__ __forceinline__ float exp_c(float x) { return __expf(fminf(x, 80.f)); }
__device__ __forceinline__ float wave_sum(float v) {
#pragma unroll
    for (int o = 1; o < 64; o <<= 1) v += __shfl_xor(v, o);
    return v;
}
__device__ __forceinline__ float sum16(float v) { v += __shfl_xor(v, 1); v += __shfl_xor(v, 2); v += __shfl_xor(v, 4); v += __shfl_xor(v, 8); return v; }
__device__ __forceinline__ float max16(float v) { v = fmaxf(v, __shfl_xor(v, 1)); v = fmaxf(v, __shfl_xor(v, 2)); v = fmaxf(v, __shfl_xor(v, 4)); v = fmaxf(v, __shfl_xor(v, 8)); return v; }
#define MFMA16(a, b, c) __builtin_amdgcn_mfma_f32_16x16x32_bf16((a), (b), (c), 0, 0, 0)
#define LDS_WAIT() asm volatile("s_waitcnt lgkmcnt(0)" ::: "memory")

template <int MODE> struct Epi {
    static constexpr bool PERM = true, AFTER_DRAIN = false;
    bf16_t* O; float* Gout; const float* lbv; int ldc;
    __device__ __forceinline__ void operator()(const f32x4 (&acc)[2][2][4][2], const pg8::Unit& u, int wr, int wc, int fr, int fq) const {
        const int row0 = u.pm * 256 + wr * 64 + fr;
        const int pn = u.pn;
#pragma unroll
        for (int ai = 0; ai < 2; ++ai)
#pragma unroll
            for (int m = 0; m < 4; ++m) {
                const size_t row = (size_t)(row0 + ai * 128 + m * 16);
                if (MODE == 3) {
                    const int col = pn * 128 + wc * 32 + fq * 8;
                    const f32x4 g0 = acc[ai][0][m][0], g1 = acc[ai][0][m][1], u0 = acc[ai][1][m][0], u1 = acc[ai][1][m][1];
                    u32x4 w;
                    w.x = pk2(silu_f(g0[0]) * u0[0], silu_f(g0[1]) * u0[1]); w.y = pk2(silu_f(g0[2]) * u0[2], silu_f(g0[3]) * u0[3]);
                    w.z = pk2(silu_f(g1[0]) * u1[0], silu_f(g1[1]) * u1[1]); w.w = pk2(silu_f(g1[2]) * u1[2], silu_f(g1[3]) * u1[3]);
                    *(u32x4*)(O + row * ldc + col) = w;
                } else {
#pragma unroll
                    for (int bj = 0; bj < 2; ++bj) {
                        const int c0 = pn * 256 + bj * 128 + wc * 32 + fq * 8;
                        f32x4 v0 = acc[ai][bj][m][0], v1 = acc[ai][bj][m][1];
                        if (MODE == 2) {
                            u32x4 w; w.x = pk2(v0[0], v0[1]); w.y = pk2(v0[2], v0[3]); w.z = pk2(v1[0], v1[1]); w.w = pk2(v1[2], v1[3]);
                            *(u32x4*)(O + row * ldc + c0) = w;
                        } else {
                            if (pn >= 8 && pn < 12) {
                                const int gc = c0 - 2048;
                                const f32x4 l0 = *(const f32x4*)(lbv + gc), l1 = *(const f32x4*)(lbv + gc + 4);
                                f32x4 o0, o1;
#pragma unroll
                                for (int e = 0; e < 4; ++e) {
                                    o0[e] = __logf(l0[e] + (1.f - l0[e]) / (1.f + __expf(-v0[e])));
                                    o1[e] = __logf(l1[e] + (1.f - l1[e]) / (1.f + __expf(-v1[e])));
                                }
                                *(f32x4*)(Gout + row * 1024 + gc) = o0; *(f32x4*)(Gout + row * 1024 + gc + 4) = o1;
                            } else {
                                if (pn < 2) { v0 = v0 * 0.125f; v1 = v1 * 0.125f; }
                                if (pn == 6 || pn == 7 || pn >= 14) {
#pragma unroll
                                    for (int e = 0; e < 4; ++e) { v0[e] = silu_f(v0[e]); v1[e] = silu_f(v1[e]); }
                                }
                                const int col = pn >= 12 ? c0 - 1024 : c0;
                                u32x4 w; w.x = pk2(v0[0], v0[1]); w.y = pk2(v0[2], v0[3]); w.z = pk2(v1[0], v1[1]); w.w = pk2(v1[2], v1[3]);
                                *(u32x4*)(O + row * PBP + col) = w;
                            }
                        }
                    }
                }
            }
    }
};

struct Sched1 {
    pg8::StaticOrder so;
    __device__ bool next(int i, pg8::Unit& u) const {
        const long L = (long)i * so.G + so.c;
        if (L < 1024) return so.next(i, u);
        const int e = (int)(L - 1024); if (e >= 20) return false;
        const int t = e % 10; u.pm = 64 + e / 10; u.pn = t < 4 ? 2 + t : 4 + t;
        return true;
    }
    __device__ __forceinline__ void a_ready(const pg8::Unit&) const {}
    __device__ __forceinline__ void done(const pg8::Unit&) const {}
};

__device__ __forceinline__ void transpose_tile(const float* W, int N, bf16_t* WT, int K, int k0, int n0, int drow0, LAS unsigned char* lds, int tid) {
    LAS bf16_t* tl = (LAS bf16_t*)lds;
    const int kr = tid >> 4, nc = (tid & 15) * 4;
#pragma unroll
    for (int h = 0; h < 2; ++h) {
        const int k = kr + 32 * h;
        const f32x4 v = *(const f32x4*)(W + (size_t)(k0 + k) * N + n0 + nc);
        tl[(nc + 0) * 72 + k] = (bf16_t)f2bf(v[0]); tl[(nc + 1) * 72 + k] = (bf16_t)f2bf(v[1]);
        tl[(nc + 2) * 72 + k] = (bf16_t)f2bf(v[2]); tl[(nc + 3) * 72 + k] = (bf16_t)f2bf(v[3]);
    }
    __syncthreads();
    const int n = tid >> 3, kc = (tid & 7) * 8;
    const u32x4 o = *(const LAS u32x4*)(tl + n * 72 + kc);
    *(u32x4*)(WT + (size_t)(drow0 + n) * K + k0 + kc) = o;
    __syncthreads();
}

__device__ __forceinline__ void p0_prologue(const Params& p, LAS unsigned char* lds, int bid, int G, int tid) {
    unsigned char* ws = p.ws;
    float* mod = (float*)(ws + WS_MOD);
    if (bid == G - 1) {
        const float* lbl = p.in[12]; float* lbv = (float*)(ws + WS_LB);
        for (int c = tid; c < 1024; c += NTHREADS) lbv[c] = 1.f / (1.f + expf(lbl[1024 + c] - lbl[c]));
    }
    for (int j = bid; j < 192; j += G) {
        const float* w_ada = p.in[4]; const float* cvec = p.in[1]; const float* cctx = p.in[3];
        const int n0 = j * 32, rl = tid >> 3, cl = (tid & 7) * 4;
        f32x4 a0 = {0.f, 0.f, 0.f, 0.f}, a1 = a0, a2 = a0;
#pragma unroll 8
        for (int pp = 0; pp < 16; ++pp) {
            const int k = pp * 64 + rl;
            const f32x4 w = *(const f32x4*)(w_ada + (size_t)k * 6144 + n0 + cl);
            const float s0 = silu_f(cvec[k]), s1 = silu_f(cvec[1024 + k]), s2 = silu_f(cctx[k]);
            a0 += w * s0; a1 += w * s1; a2 += w * s2;
        }
        LAS float* red = (LAS float*)lds;
        *(LAS f32x4*)(red + (rl * 3 + 0) * 32 + cl) = a0; *(LAS f32x4*)(red + (rl * 3 + 1) * 32 + cl) = a1; *(LAS f32x4*)(red + (rl * 3 + 2) * 32 + cl) = a2;
        __syncthreads();
        if (tid < 96) {
            const int r = tid >> 5, n = tid & 31; float s = p.in[5][n0 + n];
            for (int q = 0; q < 64; ++q) s += red[(q * 3 + r) * 32 + n];
            mod[r * 6144 + n0 + n] = s;
        }
        __syncthreads();
    }
    constexpr int I1 = 16 * 64, I2 = 16 * 16, I3 = 16 * 88, I4 = 44 * 16;
    for (int it = bid; it < I1 + I2 + I3 + I4; it += G) {
        int r = it;
        if (r < I1) { const int kt = r / 64, nt = r % 64; transpose_tile(p.in[10], NIN, (bf16_t*)(ws + WS_WT1), D, kt * 64, nt * 64, nt * 64, lds, tid); continue; } r -= I1;
        if (r < I2) { const int kt = r / 16, nt = r % 16; transpose_tile(p.in[14], D, (bf16_t*)(ws + WS_WT2), D, kt * 64, nt * 64, nt * 64, lds, tid); continue; } r -= I2;
        if (r < I3) { const int kt = r / 88, nt = r % 88; const int n0 = nt * 64; int drow;
            if (n0 < DFF) drow = (n0 / 128) * 256 + (n0 % 128); else { const int mm = n0 - DFF; drow = (mm / 128) * 256 + 128 + (mm % 128); }
            transpose_tile(p.in[15], NFF2, (bf16_t*)(ws + WS_WT3), D, kt * 64, n0, drow, lds, tid); continue; } r -= I3;
        { const int kt = r / 16, nt = r % 16; transpose_tile(p.in[16], D, (bf16_t*)(ws + WS_WT4), DFF, kt * 64, nt * 64, nt * 64, lds, tid); }
    }
}

__device__ __forceinline__ void p1_rows(const Params& p, int bid, int G, int tid) {
    const int lane = tid & 63, wave = tid >> 6;
    const float* mod = (const float*)(p.ws + WS_MOD); const float* npre = p.in[6];
    bf16_t* Hn = (bf16_t*)(p.ws + WS_HN);
    for (int m = bid * 8 + wave; m < MTOT; m += G * 8) {
        const float* src; int mr;
        if (m < MROWS) { src = p.in[0] + (size_t)m * D; mr = m >> 13; } else { src = p.in[2] + (size_t)(m - MROWS) * D; mr = 2; }
        f32x4 v[4]; float ss = 0.f;
#pragma unroll
        for (int j = 0; j < 4; ++j) { v[j] = ((const f32x4*)src)[lane + 64 * j]; ss += (v[j][0] * v[j][0] + v[j][1] * v[j][1]) + (v[j][2] * v[j][2] + v[j][3] * v[j][3]); }
        ss = wave_sum(ss);
        const float rinv = rsqrtf(ss * (1.f / D) + EPS);
        const float* mrow = mod + mr * 6144;
#pragma unroll
        for (int j = 0; j < 4; ++j) {
            const int col = (lane + 64 * j) * 4;
            const f32x4 w = *(const f32x4*)(npre + col), sc = *(const f32x4*)(mrow + 1024 + col), sh = *(const f32x4*)(mrow + col);
            const f32x4 h = v[j] * rinv * w * (sc + 1.f) + sh;
            u32x2 o; o.x = pk2(h[0], h[1]); o.y = pk2(h[2], h[3]);
            *(u32x2*)(Hn + (size_t)m * D + col) = o;
        }
    }
}

__device__ __forceinline__ void p7_rows(const Params& p, int bid, int G, int tid) {
    const int lane = tid & 63, wave = tid >> 6;
    const float* mod = (const float*)(p.ws + WS_MOD); const float* npost = p.in[7]; const float* nfpre = p.in[8];
    const bf16_t* Y2 = (const bf16_t*)(p.ws + WS_PB); bf16_t* Hn = (bf16_t*)(p.ws + WS_HN);
    for (int m = bid * 8 + wave; m < MROWS; m += G * 8) {
        const float* mrow = mod + (m >> 13) * 6144;
        f32x4 y[4], xv[4]; float ss = 0.f;
#pragma unroll
        for (int j = 0; j < 4; ++j) {
            const int col = (lane + 64 * j) * 4;
            const u32x2 yy = *(const u32x2*)(Y2 + (size_t)m * D + col);
            y[j][0] = bf2f(yy.x & 0xffffu); y[j][1] = bf2f(yy.x >> 16); y[j][2] = bf2f(yy.y & 0xffffu); y[j][3] = bf2f(yy.y >> 16);
            xv[j] = *(const f32x4*)(p.in[0] + (size_t)m * D + col);
            ss += (y[j][0] * y[j][0] + y[j][1] * y[j][1]) + (y[j][2] * y[j][2] + y[j][3] * y[j][3]);
        }
        ss = wave_sum(ss);
        const float rinv = rsqrtf(ss * (1.f / D) + EPS);
        float s1 = 0.f;
#pragma unroll
        for (int j = 0; j < 4; ++j) {
            const int col = (lane + 64 * j) * 4;
            const f32x4 w = *(const f32x4*)(npost + col), gt = *(const f32x4*)(mrow + 2048 + col);
            xv[j] = xv[j] + gt * (y[j] * rinv * w);
            *(f32x4*)(p.out + (size_t)m * D + col) = xv[j];
            s1 += (xv[j][0] * xv[j][0] + xv[j][1] * xv[j][1]) + (xv[j][2] * xv[j][2] + xv[j][3] * xv[j][3]);
        }
        s1 = wave_sum(s1);
        const float r1 = rsqrtf(s1 * (1.f / D) + EPS);
#pragma unroll
        for (int j = 0; j < 4; ++j) {
            const int col = (lane + 64 * j) * 4;
            const f32x4 w = *(const f32x4*)(nfpre + col), sc = *(const f32x4*)(mrow + 4096 + col), sh = *(const f32x4*)(mrow + 3072 + col);
            const f32x4 h = xv[j] * r1 * w * (sc + 1.f) + sh;
            u32x2 o; o.x = pk2(h[0], h[1]); o.y = pk2(h[2], h[3]);
            *(u32x2*)(Hn + (size_t)m * D + col) = o;
        }
    }
}

__device__ __forceinline__ void p10_rows(const Params& p, int bid, int G, int tid) {
    const int lane = tid & 63, wave = tid >> 6;
    const float* mod = (const float*)(p.ws + WS_MOD); const float* nfpost = p.in[9];
    const bf16_t* FF = (const bf16_t*)(p.ws + WS_G);
    for (int m = bid * 8 + wave; m < MROWS; m += G * 8) {
        const float* mrow = mod + (m >> 13) * 6144;
        f32x4 y[4]; float ss = 0.f;
#pragma unroll
        for (int j = 0; j < 4; ++j) {
            const int col = (lane + 64 * j) * 4;
            const u32x2 yy = *(const u32x2*)(FF + (size_t)m * D + col);
            y[j][0] = bf2f(yy.x & 0xffffu); y[j][1] = bf2f(yy.x >> 16); y[j][2] = bf2f(yy.y & 0xffffu); y[j][3] = bf2f(yy.y >> 16);
            ss += (y[j][0] * y[j][0] + y[j][1] * y[j][1]) + (y[j][2] * y[j][2] + y[j][3] * y[j][3]);
        }
        ss = wave_sum(ss);
        const float rinv = rsqrtf(ss * (1.f / D) + EPS);
#pragma unroll
        for (int j = 0; j < 4; ++j) {
            const int col = (lane + 64 * j) * 4;
            const f32x4 w = *(const f32x4*)(nfpost + col), gt = *(const f32x4*)(mrow + 5120 + col);
            const f32x4 x1 = *(const f32x4*)(p.out + (size_t)m * D + col);
            *(f32x4*)(p.out + (size_t)m * D + col) = x1 + gt * (y[j] * rinv * w);
        }
    }
}

__device__ __forceinline__ void na_phase(const Params& p, LAS unsigned char* lds, int bid, int G, int tid) {
    const bf16_t* PB = (const bf16_t*)(p.ws + WS_PB); const float* rpb = p.in[11]; bf16_t* Ycat = (bf16_t*)(p.ws + WS_HN);
    const int lane = tid & 63, wave = __builtin_amdgcn_readfirstlane(tid >> 6), hl = wave >> 2, qg = wave & 3, l15 = lane & 15, quad = lane >> 4;
    LAS unsigned char* sK = lds;
    LAS unsigned char* sV = lds + 18432;
    LAS unsigned char* sP = lds + 36864 + wave * 2304;
    LAS float* sR = (LAS float*)(lds + 55296);
    for (int it = bid; it < 1024; it += G) {
        const int b = it >> 9, r = (it >> 2) & 127, hp = it & 3;
        const int head = hp * 2 + hl;
        const int r0 = min(max(r - 4, 0), 120);
        __syncthreads();
        for (int i = tid; i < 930; i += NTHREADS) sR[(i / 465) * 480 + (i % 465)] = rpb[hp * 930 + i];
        const size_t qrow = (size_t)b * T + r * 64 + qg * 16 + l15;
        bf16x8 aq[2];
#pragma unroll
        for (int ks = 0; ks < 2; ++ks) aq[ks] = *(const bf16x8*)(PB + qrow * PBP + head * 64 + ks * 32 + quad * 8);
        f32x4 o[4]; float mrow[4], lrow[4];
#pragma unroll
        for (int i = 0; i < 4; ++i) { o[i] = (f32x4){0.f, 0.f, 0.f, 0.f}; mrow[i] = -1e30f; lrow[i] = 0.f; }
        for (int kb = 0; kb < 12; ++kb) {
            const size_t krow0 = (kb < 4) ? (size_t)MROWS + b * LC + kb * 64 : (size_t)b * T + (size_t)(r0 + kb - 4) * 64;
            __syncthreads();
#pragma unroll
            for (int h2 = 0; h2 < 2; ++h2) {
                const int idx = tid + 512 * h2, hh = idx >> 9, key = (idx >> 3) & 63, ch = idx & 7;
                const bf16_t* src = PB + (krow0 + key) * PBP + (hp * 2 + hh) * 64 + ch * 8;
                const u32x4 kv = *(const u32x4*)(src + 512);
                const u32x4 vv = *(const u32x4*)(src + 1024);
                *(LAS u32x4*)(sK + hh * 9216 + key * 144 + ch * 16) = kv;
                LAS bf16_t* vt = (LAS bf16_t*)(sV + hh * 9216);
                const int kphys = (((key >> 3) ^ ch) << 3) | (key & 7);
#pragma unroll
                for (int e = 0; e < 4; ++e) {
                    vt[(ch * 8 + 2 * e) * 72 + kphys] = (bf16_t)(vv[e] & 0xffffu);
                    vt[(ch * 8 + 2 * e + 1) * 72 + kphys] = (bf16_t)(vv[e] >> 16);
                }
            }
            __syncthreads();
            f32x4 s[4];
#pragma unroll
            for (int nt = 0; nt < 4; ++nt) {
                s[nt] = (f32x4){0.f, 0.f, 0.f, 0.f};
#pragma unroll
                for (int ks = 0; ks < 2; ++ks) {
                    const bf16x8 bk = *(const LAS bf16x8*)(sK + hl * 9216 + (nt * 16 + l15) * 144 + ks * 64 + quad * 16);
                    s[nt] = MFMA16(aq[ks], bk, s[nt]);
                }
            }
            if (kb >= 4) {
                const int dr = r0 + (kb - 4) - r + 7;
#pragma unroll
                for (int nt = 0; nt < 4; ++nt)
#pragma unroll
                    for (int j = 0; j < 4; ++j) {
                        const int cq = qg * 16 + quad * 4 + j, kc = nt * 16 + l15;
                        const int c0 = min(max(cq - 8, 0), 48);
                        const bool valid = (kc >= c0) && (kc <= c0 + 15);
                        const int dc = min(max(kc - cq + 15, 0), 30);
                        const float bias = sR[hl * 480 + dr * 31 + dc];
                        s[nt][j] = valid ? s[nt][j] + bias : -1e30f;
                    }
            }
#pragma unroll
            for (int j = 0; j < 4; ++j) {
                float mx = fmaxf(fmaxf(s[0][j], s[1][j]), fmaxf(s[2][j], s[3][j]));
                mx = max16(mx);
                const float mnew = fmaxf(mrow[j], mx);
                const float alpha = __expf(mrow[j] - mnew);
                mrow[j] = mnew;
                float rs = 0.f;
#pragma unroll
                for (int nt = 0; nt < 4; ++nt) { const float pv = __expf(s[nt][j] - mnew); s[nt][j] = pv; rs += pv; }
                rs = sum16(rs);
                lrow[j] = lrow[j] * alpha + rs;
#pragma unroll
                for (int nt = 0; nt < 4; ++nt) o[nt][j] *= alpha;
            }
#pragma unroll
            for (int nt = 0; nt < 4; ++nt)
#pragma unroll
                for (int j = 0; j < 4; ++j) ((LAS bf16_t*)sP)[(quad * 4 + j) * 72 + nt * 16 + l15] = (bf16_t)f2bf(s[nt][j]);
            LDS_WAIT();
            bf16x8 ap[2];
#pragma unroll
            for (int ks = 0; ks < 2; ++ks) ap[ks] = *(const LAS bf16x8*)(sP + l15 * 144 + ks * 64 + quad * 16);
#pragma unroll
            for (int nt = 0; nt < 4; ++nt) {
                const int d = nt * 16 + l15;
#pragma unroll
                for (int ks = 0; ks < 2; ++ks) {
                    const int phys = (ks * 4 + quad) ^ ((d >> 3) & 7);
                    const bf16x8 bv = *(const LAS bf16x8*)(sV + hl * 9216 + d * 144 + phys * 16);
                    o[nt] = MFMA16(ap[ks], bv, o[nt]);
                }
            }
        }
#pragma unroll
        for (int j = 0; j < 4; ++j) {
            const float inv = 1.f / lrow[j];
            const size_t tok = (size_t)b * T + r * 64 + qg * 16 + quad * 4 + j;
#pragma unroll
            for (int nt = 0; nt < 4; ++nt) Ycat[tok * 1024 + head * 64 + nt * 16 + l15] = (bf16_t)f2bf(o[nt][j] * inv);
        }
    }
}

__device__ __forceinline__ void v_tile_to_lds(const bf16_t* PB, size_t row0, int h, LAS unsigned char* sVT, int tid) {
    LAS bf16_t* vt = (LAS bf16_t*)sVT;
#pragma unroll
    for (int h2 = 0; h2 < 2; ++h2) {
        const int idx = tid + 512 * h2, s = idx >> 4, ch = idx & 15;
        const u32x4 vv = *(const u32x4*)(PB + (row0 + s) * PBP + 2048 + h * 128 + ch * 8);
        const int sphys = (((s >> 3) ^ (ch & 7)) << 3) | (s & 7);
#pragma unroll
        for (int e = 0; e < 4; ++e) {
            vt[(ch * 8 + 2 * e) * 72 + sphys] = (bf16_t)(vv[e] & 0xffffu);
            vt[(ch * 8 + 2 * e + 1) * 72 + sphys] = (bf16_t)(vv[e] >> 16);
        }
    }
}

__device__ __forceinline__ void gla_a1(const Params& p, LAS unsigned char* lds, int bid, int G, int tid) {
    const bf16_t* PB = (const bf16_t*)(p.ws + WS_PB); const float* Gb = (const float*)(p.ws + WS_G);
    float* dec = (float*)(p.ws + WS_DEC);
    const int lane = tid & 63, wave = __builtin_amdgcn_readfirstlane(tid >> 6), l15 = lane & 15, quad = lane >> 4;
    LAS unsigned char* sKh = lds;
    LAS unsigned char* sVT = lds + 18432;
    LAS float* sTot = (LAS float*)(lds + 36864);
    const int k = tid & 127, sq = tid >> 7;
    for (int id = bid; id < N_ITEMS; id += G) {
        int chain; size_t row0; bf16_t* slot;
        if (id < N_LAT_ITEMS) { chain = id >> 7; row0 = (size_t)(chain >> 3) * T + (size_t)(id & 127) * 64; slot = (bf16_t*)((unsigned char*)p.out + (size_t)id * 32768); }
        else { const int e = id - N_LAT_ITEMS; chain = e >> 2; row0 = (size_t)MROWS + (size_t)(chain >> 3) * LC + (size_t)(e & 3) * 64; slot = (bf16_t*)(p.ws + WS_UCTX + (size_t)e * 32768); }
        const int h = (chain >> 1) & 3, dir = chain & 1;
        const float* gp = Gb + (row0 + sq * 16) * 1024 + dir * 512 + h * 128 + k;
        float g[16], pre[16];
#pragma unroll
        for (int i = 0; i < 16; ++i) g[i] = gp[(size_t)i * 1024];
        float run = 0.f;
        if (dir == 0) {
#pragma unroll
            for (int i = 0; i < 16; ++i) { run += g[i]; pre[i] = run; }
        } else {
#pragma unroll
            for (int i = 15; i >= 0; --i) { run += g[i]; pre[i] = run; }
        }
        sTot[sq * 128 + k] = run;
        v_tile_to_lds(PB, row0, h, sVT, tid);
        __syncthreads();
        const float t0 = sTot[k], t1 = sTot[128 + k], t2 = sTot[256 + k], t3 = sTot[384 + k];
        const float total = (t0 + t1) + (t2 + t3);
        float off;
        if (dir == 0) off = (sq > 0 ? t0 : 0.f) + (sq > 1 ? t1 : 0.f) + (sq > 2 ? t2 : 0.f);
        else off = (sq < 1 ? t1 : 0.f) + (sq < 2 ? t2 : 0.f) + (sq < 3 ? t3 : 0.f);
        u32x4 w0, w1;
        {
            float kh[16];
#pragma unroll
            for (int i = 0; i < 16; ++i) kh[i] = (1.f - __expf(g[i])) * __expf(total - off - pre[i]);
            w0.x = pk2(kh[0], kh[1]); w0.y = pk2(kh[2], kh[3]); w0.z = pk2(kh[4], kh[5]); w0.w = pk2(kh[6], kh[7]);
            w1.x = pk2(kh[8], kh[9]); w1.y = pk2(kh[10], kh[11]); w1.z = pk2(kh[12], kh[13]); w1.w = pk2(kh[14], kh[15]);
        }
        *(LAS u32x4*)(sKh + k * 144 + sq * 32) = w0; *(LAS u32x4*)(sKh + k * 144 + sq * 32 + 16) = w1;
        if (sq == 0) dec[(size_t)id * 128 + k] = __expf(total);
        __syncthreads();
        f32x4 acc[8];
#pragma unroll
        for (int nt = 0; nt < 8; ++nt) acc[nt] = (f32x4){0.f, 0.f, 0.f, 0.f};
        bf16x8 a[2];
        {
            const int v = wave * 16 + l15;
#pragma unroll
            for (int ks = 0; ks < 2; ++ks) { const int phys = (ks * 4 + quad) ^ ((v >> 3) & 7); a[ks] = *(const LAS bf16x8*)(sVT + v * 144 + phys * 16); }
        }
#pragma unroll
        for (int nt = 0; nt < 8; ++nt)
#pragma unroll
            for (int ks = 0; ks < 2; ++ks) {
                const bf16x8 bb = *(const LAS bf16x8*)(sKh + (nt * 16 + l15) * 144 + ks * 64 + quad * 16);
                acc[nt] = MFMA16(a[ks], bb, acc[nt]);
            }
#pragma unroll
        for (int nt = 0; nt < 8; ++nt)
#pragma unroll
            for (int j = 0; j < 4; ++j) slot[(wave * 16 + quad * 4 + j) * 128 + nt * 16 + l15] = (bf16_t)f2bf(acc[nt][j]);
        __syncthreads();
    }
}

__device__ __forceinline__ void gla_scan(const Params& p, int bid, int G, int tid) {
    const float* dec = (const float*)(p.ws + WS_DEC);
    for (int gt = bid * NTHREADS + tid; gt < 16 * 8192; gt += G * NTHREADS) {
        const int chain = gt >> 13, e = gt & 8191, dir = chain & 1, kk = (2 * e) & 127;
        float s0 = 0.f, s1 = 0.f;
#pragma unroll
        for (int j = 0; j < 4; ++j) {
            const int idc = chain * 4 + (dir ? 3 - j : j);
            const unsigned u = *(const unsigned*)(p.ws + WS_UCTX + (size_t)idc * 32768 + (size_t)e * 4);
            const f32x2 d = *(const f32x2*)(dec + (size_t)(N_LAT_ITEMS + idc) * 128 + kk);
            s0 = d.x * s0 + bf2f(u & 0xffffu); s1 = d.y * s1 + bf2f(u >> 16);
        }
        unsigned char* base = (unsigned char*)p.out + (size_t)chain * 128 * 32768 + (size_t)e * 4;
        const float* dbase = dec + (size_t)chain * 128 * 128 + kk;
        for (int jb = 0; jb < 16; ++jb) {
            unsigned u[8]; f32x2 d[8];
#pragma unroll
            for (int i = 0; i < 8; ++i) {
                const int j = jb * 8 + i, c = dir ? 127 - j : j;
                u[i] = *(const unsigned*)(base + (size_t)c * 32768);
                d[i] = *(const f32x2*)(dbase + (size_t)c * 128);
            }
#pragma unroll
            for (int i = 0; i < 8; ++i) {
                const int j = jb * 8 + i, c = dir ? 127 - j : j;
                *(unsigned*)(base + (size_t)c * 32768) = pk2(s0, s1);
                s0 = d[i].x * s0 + bf2f(u[i] & 0xffffu); s1 = d[i].y * s1 + bf2f(u[i] >> 16);
            }
        }
    }
}

__device__ __forceinline__ void gla_a3(const Params& p, LAS unsigned char* lds, int bid, int G, int tid) {
    const bf16_t* PB = (const bf16_t*)(p.ws + WS_PB); const float* Gb = (const float*)(p.ws + WS_G);
    const float* hgw = p.in[13]; bf16_t* Ycat = (bf16_t*)(p.ws + WS_HN);
    const int lane = tid & 63, wave = __builtin_amdgcn_readfirstlane(tid >> 6), l15 = lane & 15, quad = lane >> 4;
    const int mt = wave & 3, nh = wave >> 2;
    LAS unsigned char* sQh = lds;
    LAS unsigned char* sQt = lds + 17408;
    LAS unsigned char* sKt = lds + 34816;
    LAS unsigned char* sVT = lds + 52224;
    LAS unsigned char* sP = lds + 70656 + wave * 2304;
    LAS float* sTot = (LAS float*)(lds + 89088);
    LAS float* sSS = (LAS float*)(lds + 91136);
    const int k = tid & 127, sq = tid >> 7;
    for (int it = bid; it < 1024; it += G) {
        const int b = it >> 9, h = (it >> 7) & 3, c = it & 127;
        const size_t row0 = (size_t)b * T + (size_t)c * 64;
        __syncthreads();
        v_tile_to_lds(PB, row0, h, sVT, tid);
        f32x4 acc[4];
#pragma unroll
        for (int nt = 0; nt < 4; ++nt) acc[nt] = (f32x4){0.f, 0.f, 0.f, 0.f};
#pragma unroll 1
        for (int dir = 0; dir < 2; ++dir) {
            if (dir) __syncthreads();
            const float* gp = Gb + (row0 + sq * 16) * 1024 + dir * 512 + h * 128 + k;
            float g[16], pre[16];
#pragma unroll
            for (int i = 0; i < 16; ++i) g[i] = gp[(size_t)i * 1024];
            float run = 0.f;
            if (dir == 0) {
#pragma unroll
                for (int i = 0; i < 16; ++i) { run += g[i]; pre[i] = run; }
            } else {
#pragma unroll
                for (int i = 15; i >= 0; --i) { run += g[i]; pre[i] = run; }
            }
            sTot[sq * 128 + k] = run;
            __syncthreads();
            const float t0 = sTot[k], t1 = sTot[128 + k], t2 = sTot[256 + k], t3 = sTot[384 + k];
            const float total = (t0 + t1) + (t2 + t3);
            float off;
            if (dir == 0) off = (sq > 0 ? t0 : 0.f) + (sq > 1 ? t1 : 0.f) + (sq > 2 ? t2 : 0.f);
            else off = (sq < 1 ? t1 : 0.f) + (sq < 2 ? t2 : 0.f) + (sq < 3 ? t3 : 0.f);
            const float rr = 0.5f * total;
            const bf16_t* qp = PB + (row0 + sq * 16) * PBP + 1536 + h * 128 + k;
#pragma unroll
            for (int i = 0; i < 16; ++i) {
                const int s = sq * 16 + i;
                const float bs = off + pre[i];
                const float qv = bf2f((unsigned)qp[(size_t)i * PBP]);
                const float qh = qv * __expf(bs), qt = qv * exp_c(bs - rr), kt = (1.f - __expf(g[i])) * exp_c(rr - bs);
                ((LAS bf16_t*)sQh)[s * 136 + k] = (bf16_t)f2bf(qh);
                ((LAS bf16_t*)sQt)[s * 136 + k] = (bf16_t)f2bf(qt);
                ((LAS bf16_t*)sKt)[s * 136 + k] = (bf16_t)f2bf(kt);
            }
            __syncthreads();
            const bf16_t* Sp = (const bf16_t*)((const unsigned char*)p.out + (size_t)((((b * 4 + h) * 2 + dir) * 128) + c) * 32768);
#pragma unroll
            for (int ks = 0; ks < 4; ++ks) {
                const bf16x8 a = *(const LAS bf16x8*)(sQh + (mt * 16 + l15) * 272 + ks * 64 + quad * 16);
#pragma unroll
                for (int nt = 0; nt < 4; ++nt) {
                    const int v = nh * 64 + nt * 16 + l15;
                    const bf16x8 bs_ = *(const bf16x8*)(Sp + v * 128 + ks * 32 + quad * 8);
                    acc[nt] = MFMA16(a, bs_, acc[nt]);
                }
            }
            f32x4 at[4];
#pragma unroll
            for (int st = 0; st < 4; ++st) at[st] = (f32x4){0.f, 0.f, 0.f, 0.f};
#pragma unroll
            for (int ks = 0; ks < 4; ++ks) {
                const bf16x8 a = *(const LAS bf16x8*)(sQt + (mt * 16 + l15) * 272 + ks * 64 + quad * 16);
#pragma unroll
                for (int st = 0; st < 4; ++st) {
                    const bf16x8 bk = *(const LAS bf16x8*)(sKt + (st * 16 + l15) * 272 + ks * 64 + quad * 16);
                    at[st] = MFMA16(a, bk, at[st]);
                }
            }
#pragma unroll
            for (int st = 0; st < 4; ++st)
#pragma unroll
                for (int j = 0; j < 4; ++j) {
                    const int i_ = mt * 16 + quad * 4 + j, s_ = st * 16 + l15;
                    const bool keep = dir ? (s_ >= i_) : (s_ <= i_);
                    ((LAS bf16_t*)sP)[(quad * 4 + j) * 72 + s_] = (bf16_t)f2bf(keep ? at[st][j] : 0.f);
                }
            LDS_WAIT();
            bf16x8 ap[2];
#pragma unroll
            for (int ks = 0; ks < 2; ++ks) ap[ks] = *(const LAS bf16x8*)(sP + l15 * 144 + ks * 64 + quad * 16);
#pragma unroll
            for (int nt = 0; nt < 4; ++nt) {
                const int v = nh * 64 + nt * 16 + l15;
#pragma unroll
                for (int ks = 0; ks < 2; ++ks) {
                    const int phys = (ks * 4 + quad) ^ ((v >> 3) & 7);
                    const bf16x8 bv = *(const LAS bf16x8*)(sVT + v * 144 + phys * 16);
                    acc[nt] = MFMA16(ap[ks], bv, acc[nt]);
                }
            }
        }
#pragma unroll
        for (int j = 0; j < 4; ++j) {
            float ss = (acc[0][j] * acc[0][j] + acc[1][j] * acc[1][j]) + (acc[2][j] * acc[2][j] + acc[3][j] * acc[3][j]);
            ss = sum16(ss);
            if (l15 == 0) sSS[nh * 64 + mt * 16 + quad * 4 + j] = ss;
        }
        __syncthreads();
#pragma unroll
        for (int j = 0; j < 4; ++j) {
            const int i_ = mt * 16 + quad * 4 + j;
            const float tot = sSS[i_] + sSS[64 + i_];
            const float rinv = rsqrtf(tot * (1.f / 128.f) + EPS);
#pragma unroll
            for (int nt = 0; nt < 4; ++nt) {
                const int v = nh * 64 + nt * 16 + l15;
                const float gate = bf2f((unsigned)PB[(row0 + i_) * PBP + 2560 + h * 128 + v]);
                Ycat[(row0 + i_) * 1024 + 512 + h * 128 + v] = (bf16_t)f2bf(acc[nt][j] * rinv * hgw[v] * gate);
            }
        }
    }
}

__global__ void __launch_bounds__(NTHREADS, 2) mega_fwd(Params p) {
    extern __shared__ __attribute__((aligned(16))) unsigned char lds_raw[];
    LAS unsigned char* lds = (LAS unsigned char*)lds_raw;
    cg::grid_group grid = cg::this_grid();
    const int tid = threadIdx.x, bid = blockIdx.x, G = gridDim.x;
    unsigned char* ws = p.ws;
#define IN(k) (p.ph_lo <= (k) && (k) < p.ph_hi)
#define SEAM(k) do { if (IN(k) && IN((k) + 1)) grid.sync(); } while (0)
    if (IN(0)) p0_prologue(p, lds, bid, G, tid);
    SEAM(0);
    if (IN(1)) p1_rows(p, bid, G, tid);
    SEAM(1);
    if (IN(2)) {
        pg8::Gemm g{(const bf16_t*)(ws + WS_HN), (const bf16_t*)(ws + WS_WT1), MTOT, NIN, D};
        Sched1 S; S.so.init(MROWS, NIN, G, bid);
        Epi<1> E{(bf16_t*)(ws + WS_PB), (float*)(ws + WS_G), (const float*)(ws + WS_LB), PBP};
        pg8::gemm_phase<Epi<1>, Sched1, true, true>(lds, g, S, E);
    }
    SEAM(2);
    if (IN(3)) { na_phase(p, lds, bid, G, tid); __syncthreads(); gla_a1(p, lds, bid, G, tid); }
    SEAM(3);
    if (IN(4)) gla_scan(p, bid, G, tid);
    SEAM(4);
    if (IN(5)) gla_a3(p, lds, bid, G, tid);
    SEAM(5);
    if (IN(6)) {
        __syncthreads();
        pg8::Gemm g{(const bf16_t*)(ws + WS_HN), (const bf16_t*)(ws + WS_WT2), MROWS, D, D};
        pg8::StaticOrder S; S.init(MROWS, D, G, bid);
        Epi<2> E{(bf16_t*)(ws + WS_PB), nullptr, nullptr, D};
        pg8::gemm_phase<Epi<2>, pg8::StaticOrder, true, true>(lds, g, S, E);
    }
    SEAM(6);
    if (IN(7)) p7_rows(p, bid, G, tid);
    SEAM(7);
    if (IN(8)) {
        pg8::Gemm g{(const bf16_t*)(ws + WS_HN), (const bf16_t*)(ws + WS_WT3), MROWS, NFF2, D};
        pg8::StaticOrder S; S.init(MROWS, NFF2, G, bid);
        Epi<3> E{(bf16_t*)(ws + WS_PB), nullptr, nullptr, DFF};
        pg8::gemm_phase<Epi<3>, pg8::StaticOrder, true, true>(lds, g, S, E);
    }
    SEAM(8);
    if (IN(9)) {
        pg8::Gemm g{(const bf16_t*)(ws + WS_PB), (const bf16_t*)(ws + WS_WT4), MROWS, D, DFF};
        pg8::StaticOrder S; S.init(MROWS, D, G, bid);
        Epi<2> E{(bf16_t*)(ws + WS_G), nullptr, nullptr, D};
        pg8::gemm_phase<Epi<2>, pg8::StaticOrder, true, true>(lds, g, S, E);
    }
    SEAM(9);
    if (IN(10)) p10_rows(p, bid, G, tid);
#undef IN
#undef SEAM
}

#ifndef MK_PER_PHASE
#define MK_PER_PHASE 0
#endif
extern "C" void kernel_launch(void* const* d_in, const int* in_sizes, int n_in, void* d_out, int out_size, void* d_ws, size_t ws_size, hipStream_t stream) {
    static int grid = 0;
    if (grid == 0) {
        int dev = 0, cus = 0, per_cu = 0;
        (void)hipGetDevice(&dev);
        (void)hipDeviceGetAttribute(&cus, hipDeviceAttributeMultiprocessorCount, dev);
        if (hipFuncSetAttribute((const void*)mega_fwd, hipFuncAttributeMaxDynamicSharedMemorySize, LDS_BYTES) != hipSuccess) fprintf(stderr, "hipFuncSetAttribute failed\n");
        if (hipOccupancyMaxActiveBlocksPerMultiprocessor(&per_cu, (const void*)mega_fwd, NTHREADS, LDS_BYTES) != hipSuccess || per_cu < 1) { fprintf(stderr, "occupancy query: %d\n", per_cu); per_cu = 1; }
        (void)hipGetLastError();
        if (cus <= 0) cus = 256;
        grid = cus * 1;
        if (n_in != 17 || ws_size < WS_END) fprintf(stderr, "kernel_launch: unexpected n_in %d / ws %zu\n", n_in, ws_size);
    }
    Params p{};
    for (int i = 0; i < 17; ++i) p.in[i] = (const float*)d_in[i];
    p.out = (float*)d_out; p.ws = (unsigned char*)d_ws;
#if MK_PER_PHASE
    for (int ph = 0; ph < 11; ++ph) { p.ph_lo = ph; p.ph_hi = ph + 1; hipLaunchKernelGGL(mega_fwd, dim3(grid), dim3(NTHREADS), LDS_BYTES, stream, p); }
#else
    p.ph_lo = 0; p.ph_hi = 11;
    void* args[] = {&p};
    hipError_t e = hipLaunchCooperativeKernel((const void*)mega_fwd, dim3(grid), dim3(NTHREADS), args, LDS_BYTES, stream);
    if (e != hipSuccess) fprintf(stderr, "cooperative launch failed: %s (grid %d)\n", hipGetErrorString(e), grid);
#endif
}
```

```cpp
#include <hip/hip_runtime.h>
#include <hip/hip_cooperative_groups.h>
#include <cstdio>
#include <cstdint>
namespace cg = cooperative_groups;

namespace pg8 {
#define PG8_LAS __attribute__((address_space(3)))
typedef unsigned short bf16_t;
typedef short bf16x8 __attribute__((ext_vector_type(8)));
typedef float f32x4 __attribute__((ext_vector_type(4)));
typedef unsigned u32x4 __attribute__((ext_vector_type(4)));
constexpr int BM = 256, BK = 64, HALF = 128, HTB = HALF * BK * 2  , STAGE_BYTES = 8 * HTB, NXCD = 8, WGM = 8;

__host__ __device__ __forceinline__ int lds_byte(int r, int c) { const int st = (r >> 4) * 2 + (c >> 5), rr = r & 15, cc = c & 31, ob = rr * 64 + cc * 2; return st * 1024 + (ob ^ (((ob >> 9) & 1) << 5)); }
__host__ __device__ __forceinline__ void stage_rc(int b, int& R, int& C) { const int st = b / 1024, sb = b % 1024, swz = sb ^ (((sb >> 9) & 1) << 5); R = (st >> 1) * 16 + swz / 64; C = (st & 1) * 32 + (swz % 64) / 2; }
__host__ __device__ __forceinline__ int perm32(int rho) { const int n = rho >> 4, i = rho & 15; return 8 * (i >> 2) + 4 * n + (i & 3); }

struct Unit { int pm, pn; };
struct Gemm { const bf16_t* A; const bf16_t* Bt; int M, N, K; };

struct StaticOrder {
    int nM, nN, nwg, G, c;
    __host__ __device__ void init(int M, int N, int G_, int c_) { nM = M / BM; nN = N / BM; nwg = nM * nN; G = G_; c = c_; }
    __host__ __device__ bool next(int i, Unit& u) const {
        const long L = (long)i * G + c; if (L >= nwg) return false;
        int wgid = (int)L; { const int q = nwg / NXCD, r = nwg % NXCD, xcd = wgid % NXCD, off = wgid / NXCD; wgid = (xcd < r ? xcd * (q + 1) : r * (q + 1) + (xcd - r) * q) + off; }
        const int nig = WGM * nN, gid = wgid / nig, fm = gid * WGM, gsz = (nM - fm) < WGM ? (nM - fm) : WGM;
        u.pm = fm + ((wgid % nig) % gsz); u.pn = (wgid % nig) / gsz; return true;
    }
    __device__ __forceinline__ void a_ready(const Unit&) const {}
    __device__ __forceinline__ void done(const Unit&) const {}
};
__device__ __forceinline__ unsigned cvt_pk_bf16(float lo, float hi) { unsigned r; asm volatile("v_cvt_pk_bf16_f32 %0, %1, %2" : "=v"(r) : "v"(lo), "v"(hi)); return r; }
template <class Epi, class Sched, bool ALIGN_EPI = false, bool SP2 = false>
__device__ __forceinline__ void gemm_phase(PG8_LAS unsigned char* lds, const Gemm g, const Sched& S, const Epi& E) {
    const int tid = threadIdx.x, wid = __builtin_amdgcn_readfirstlane(tid >> 6), lane = tid & 63, wr = wid >> 2, wc = wid & 3, fr = lane & 15, fq = lane >> 4;
    const int K = g.K, nt = K / BK;
    unsigned voffA[2], voffB[2];
#pragma unroll
    for (int i = 0; i < 2; ++i) { int R, C; stage_rc(tid * 16 + i * 8192, R, C); const int Rb = Epi::PERM ? ((R & ~31) + perm32(R & 31)) : R;
        voffA[i] = (unsigned)(R * K + C) * 2u; voffB[i] = (unsigned)(Rb * K + C) * 2u; }
    const size_t kstep = (size_t)(BK * 2);
    const size_t hstep = (size_t)HALF * K * 2;
    const size_t tstep = 2 * hstep;
    const unsigned ldsw = (unsigned)wid * 1024u;
    const int aoff = lds_byte(wr * 64 + fr, fq * 8), boff = lds_byte(wc * 32 + fr, fq * 8);
#define PG8_SA(b, h) (((b) * 2 + (h)) * HTB)
#define PG8_SB(b, h) ((4 + (b) * 2 + (h)) * HTB)
#define PG8_STAGE(bufoff, gbase, voff) do { _Pragma("unroll") for (int _i = 0; _i < 2; ++_i) \
        __builtin_amdgcn_global_load_lds((const unsigned*)((const char*)(gbase) + (voff)[_i]), (PG8_LAS unsigned*)(lds + (bufoff) + ldsw + _i * 8192), 16, 0, 0); } while (0)
#define PG8_LDA(dst, b, h) do { _Pragma("unroll") for (int m = 0; m < 4; ++m) _Pragma("unroll") for (int k = 0; k < 2; ++k) dst[m][k] = *(const PG8_LAS bf16x8*)(lds + PG8_SA(b, h) + aoff + m * 2048 + k * 1024); } while (0)
#define PG8_LDB(dst, b, h) do { _Pragma("unroll") for (int n = 0; n < 2; ++n) _Pragma("unroll") for (int k = 0; k < 2; ++k) dst[n][k] = *(const PG8_LAS bf16x8*)(lds + PG8_SB(b, h) + boff + n * 2048 + k * 1024); } while (0)
#define PG8_MMA(ai, bj, At, Bt) do { __builtin_amdgcn_s_setprio(1); _Pragma("unroll") for (int m = 0; m < 4; ++m) _Pragma("unroll") for (int n = 0; n < 2; ++n) _Pragma("unroll") for (int k = 0; k < 2; ++k) \
        acc[ai][bj][m][n] = __builtin_amdgcn_mfma_f32_16x16x32_bf16(Bt[n][k], At[m][k], acc[ai][bj][m][n], 0, 0, 0); __builtin_amdgcn_s_setprio(0); } while (0)
#define PG8_WAIT_V(n) asm volatile("s_waitcnt vmcnt(" #n ")" ::: "memory")
#define PG8_WAIT_L(n) asm volatile("s_waitcnt lgkmcnt(" #n ")" ::: "memory")
#define PG8_BAR __builtin_amdgcn_s_barrier()
#define PG8_SCHED __builtin_amdgcn_sched_barrier(0)
    Unit cur, nxt; int ui = 0;
    if (!S.next(0, cur)) return;
    f32x4 acc[2][2][4][2];
#pragma unroll
    for (int a = 0; a < 2; ++a)
#pragma unroll
        for (int b = 0; b < 2; ++b)
#pragma unroll
            for (int m = 0; m < 4; ++m)
#pragma unroll
                for (int n = 0; n < 2; ++n) acc[a][b][m][n] = (f32x4){0.f, 0.f, 0.f, 0.f};
    bf16x8 At[4][2], B0[2][2], B1[2][2];
    const char* cA = (const char*)g.A + (size_t)cur.pm * tstep; const char* cB = (const char*)g.Bt + (size_t)cur.pn * tstep;
    S.a_ready(cur);
    if constexpr (SP2) {
        PG8_STAGE(PG8_SB(0, 0), cB, voffB); PG8_STAGE(PG8_SB(0, 1), cB + hstep, voffB); PG8_STAGE(PG8_SA(0, 0), cA, voffA); PG8_STAGE(PG8_SA(0, 1), cA + hstep, voffA);
        if (wr == 1) PG8_BAR;
        PG8_WAIT_V(2); PG8_BAR;
        PG8_STAGE(PG8_SB(1, 0), cB + kstep, voffB); PG8_STAGE(PG8_SA(1, 0), cA + kstep, voffA); PG8_STAGE(PG8_SB(1, 1), cB + hstep + kstep, voffB);
        PG8_WAIT_V(6); PG8_BAR;
    } else {
        PG8_STAGE(PG8_SB(0, 0), cB, voffB); PG8_STAGE(PG8_SA(0, 0), cA, voffA); PG8_STAGE(PG8_SB(0, 1), cB + hstep, voffB); PG8_STAGE(PG8_SA(0, 1), cA + hstep, voffA);
        if (wr == 1) PG8_BAR;
        PG8_WAIT_V(4); PG8_BAR;
        PG8_STAGE(PG8_SB(1, 0), cB + kstep, voffB); PG8_STAGE(PG8_SA(1, 0), cA + kstep, voffA); PG8_STAGE(PG8_SB(1, 1), cB + hstep + kstep, voffB);
        PG8_WAIT_V(6); PG8_BAR;
    }
    for (;;) {
        const bool has_next = S.next(ui + 1, nxt);
        const char* nA = has_next ? (const char*)g.A + (size_t)nxt.pm * tstep : cA; const char* nB = has_next ? (const char*)g.Bt + (size_t)nxt.pn * tstep : cB;
        for (int t = 0; t < nt; t += 2) {
            const bool last = (t == nt - 2);
            const char* a1 = cA + (size_t)(t + 1) * kstep;
            const char* a2 = last ? nA : cA + (size_t)(t + 2) * kstep; const char* b2 = last ? nB : cB + (size_t)(t + 2) * kstep;
            const char* a3 = a2 + kstep; const char* b3 = b2 + kstep;
            if (last && has_next) S.a_ready(nxt);
            if constexpr (SP2) {
            PG8_LDB(B0, 0, 0); PG8_LDB(B1, 0, 1); PG8_SCHED; PG8_LDA(At, 0, 0); PG8_STAGE(PG8_SA(1, 1), a1 + hstep, voffA);
            PG8_WAIT_V(8); PG8_WAIT_L(0); PG8_BAR; PG8_MMA(0, 0, At, B0); PG8_MMA(0, 1, At, B1); PG8_BAR; PG8_SCHED;
            PG8_LDA(At, 0, 1); PG8_STAGE(PG8_SB(0, 0), b2, voffB); PG8_STAGE(PG8_SB(0, 1), b2 + hstep, voffB); PG8_STAGE(PG8_SA(0, 0), a2, voffA);
            PG8_WAIT_V(8); PG8_WAIT_L(0); PG8_BAR; PG8_MMA(1, 0, At, B0); PG8_MMA(1, 1, At, B1); PG8_BAR; PG8_SCHED;
            PG8_LDB(B0, 1, 0); PG8_LDB(B1, 1, 1); PG8_SCHED; PG8_LDA(At, 1, 0); PG8_STAGE(PG8_SA(0, 1), a2 + hstep, voffA);
            PG8_WAIT_V(8); PG8_WAIT_L(0); PG8_BAR; PG8_MMA(0, 0, At, B0); PG8_MMA(0, 1, At, B1); PG8_BAR; PG8_SCHED;
            PG8_LDA(At, 1, 1); PG8_STAGE(PG8_SB(1, 0), b3, voffB); PG8_STAGE(PG8_SB(1, 1), b3 + hstep, voffB); PG8_STAGE(PG8_SA(1, 0), a3, voffA);
            PG8_WAIT_V(8); PG8_WAIT_L(0); PG8_BAR; PG8_MMA(1, 0, At, B0); PG8_MMA(1, 1, At, B1); PG8_BAR; PG8_SCHED;
            } else {
            PG8_LDB(B0, 0, 0); PG8_SCHED; PG8_LDA(At, 0, 0); PG8_STAGE(PG8_SA(1, 1), a1 + hstep, voffA);
            PG8_WAIT_L(8); PG8_BAR; PG8_WAIT_L(0); PG8_MMA(0, 0, At, B0); PG8_BAR; PG8_SCHED;
            PG8_LDB(B1, 0, 1); PG8_STAGE(PG8_SB(0, 0), b2, voffB);
            PG8_BAR; PG8_WAIT_L(0); PG8_MMA(0, 1, At, B1); PG8_BAR;
            PG8_LDA(At, 0, 1); PG8_STAGE(PG8_SA(0, 0), a2, voffA);
            PG8_BAR; PG8_WAIT_L(0); PG8_MMA(1, 0, At, B0); PG8_BAR; PG8_SCHED;
            PG8_STAGE(PG8_SB(0, 1), b2 + hstep, voffB);
            PG8_WAIT_V(6); PG8_BAR; PG8_MMA(1, 1, At, B1); PG8_BAR;
            PG8_LDB(B0, 1, 0); PG8_SCHED; PG8_LDA(At, 1, 0); PG8_STAGE(PG8_SA(0, 1), a2 + hstep, voffA);
            PG8_WAIT_L(8); PG8_BAR; PG8_WAIT_L(0); PG8_MMA(0, 0, At, B0); PG8_BAR; PG8_SCHED;
            PG8_LDB(B1, 1, 1); PG8_STAGE(PG8_SB(1, 0), b3, voffB);
            PG8_BAR; PG8_WAIT_L(0); PG8_MMA(0, 1, At, B1); PG8_BAR;
            PG8_LDA(At, 1, 1); PG8_STAGE(PG8_SA(1, 0), a3, voffA);
            PG8_BAR; PG8_WAIT_L(0); PG8_MMA(1, 0, At, B0); PG8_BAR; PG8_SCHED;
            PG8_STAGE(PG8_SB(1, 1), b3 + hstep, voffB);
            PG8_WAIT_V(6); PG8_BAR; PG8_MMA(1, 1, At, B1); PG8_BAR;
            }
        }
        if constexpr (ALIGN_EPI) { if (wr == 0) PG8_BAR; }
        if constexpr (!Epi::AFTER_DRAIN) { E(acc, cur, wr, wc, fr, fq); S.done(cur); }
        if (!has_next) break;
#pragma unroll
        for (int a = 0; a < 2; ++a)
#pragma unroll
            for (int b = 0; b < 2; ++b)
#pragma unroll
                for (int m = 0; m < 4; ++m)
#pragma unroll
                    for (int n = 0; n < 2; ++n) acc[a][b][m][n] = (f32x4){0.f, 0.f, 0.f, 0.f};
        cur = nxt; cA = nA; cB = nB; ++ui;
        if constexpr (ALIGN_EPI) { if (wr == 1) PG8_BAR; }
    }
    PG8_WAIT_V(0);
    if constexpr (!ALIGN_EPI) { if (wr == 0) PG8_BAR; }
    PG8_BAR;
    if constexpr (Epi::AFTER_DRAIN) { E.fused(acc, cur, wr, wc, fr, fq, lds, wid, lane); S.done(cur); }
#undef PG8_SA
#undef PG8_SB
#undef PG8_STAGE
#undef PG8_LDA
#undef PG8_LDB
#undef PG8_MMA
#undef PG8_WAIT_V
#undef PG8_WAIT_L
#undef PG8_BAR
#undef PG8_SCHED
}
}

#define LAS __attribute__((address_space(3)))
typedef unsigned short bf16_t;
typedef short bf16x8 __attribute__((ext_vector_type(8)));
typedef float f32x4 __attribute__((ext_vector_type(4)));
typedef float f32x2 __attribute__((ext_vector_type(2)));
typedef unsigned u32x4 __attribute__((ext_vector_type(4)));
typedef unsigned u32x2 __attribute__((ext_vector_type(2)));

constexpr int NB = 2, T = 8192, D = 1024, LC = 256;
constexpr int MROWS = NB * T, MCTX = NB * LC, MTOT = MROWS + MCTX;
constexpr int NIN = 4096, DFF = 2816, NFF2 = 5632, PBP = 3072;
constexpr float EPS = 1e-6f;
constexpr int NTHREADS = 512;
constexpr int LDS_BYTES = 147456;
constexpr int N_LAT_ITEMS = 2048, N_ITEMS = 2112;

constexpr size_t WS_WT1 = 0;
constexpr size_t WS_WT2 = WS_WT1 + (size_t)NIN * D * 2;
constexpr size_t WS_WT3 = WS_WT2 + (size_t)D * D * 2;
constexpr size_t WS_WT4 = WS_WT3 + (size_t)NFF2 * D * 2;
constexpr size_t WS_MOD = WS_WT4 + (size_t)D * DFF * 2;
constexpr size_t WS_LB = WS_MOD + 3 * 6144 * 4;
constexpr size_t WS_CTL = WS_LB + 4096;
constexpr size_t WS_DEC = WS_CTL + 16384;
constexpr size_t WS_UCTX = WS_DEC + (size_t)N_ITEMS * 128 * 4;
constexpr size_t WS_HN = WS_UCTX + (size_t)64 * 32768;
constexpr size_t WS_PB = WS_HN + (size_t)MTOT * D * 2;
constexpr size_t WS_G = WS_PB + (size_t)MTOT * PBP * 2;
constexpr size_t WS_END = WS_G + (size_t)MTOT * 1024 * 4;
static_assert(WS_END <= 268435456, "d_ws map");

struct Params { const float* in[17]; float* out; unsigned char* ws; int ph_lo, ph_hi; };

__device__ __forceinline__ unsigned f2bf(float f) { unsigned u = __builtin_bit_cast(unsigned, f); return (u + 0x7fffu + ((u >> 16) & 1u)) >> 16; }
__device__ __forceinline__ float bf2f(unsigned h) { return __builtin_bit_cast(float, h << 16); }
__device__ __forceinline__ unsigned pk2(float lo, float hi) { return f2bf(lo) | (f2bf(hi) << 16); }
__device__ __forceinline__ float silu_f(float x) { return x / (1.f + __expf(-x)); }
__device__ __forceinline__ float exp_c(float x) { return __expf(fminf(x, 80.f)); }
__device__ __forceinline__ float wave_sum(float v) {
#pragma unroll
    for (int o = 1; o < 64; o <<= 1) v += __shfl_xor(v, o);
    return v;
}
__device__ __forceinline__ float sum16(float v) { v += __shfl_xor(v, 1); v += __shfl_xor(v, 2); v += __shfl_xor(v, 4); v += __shfl_xor(v, 8); return v; }
__device__ __forceinline__ float max16(float v) { v = fmaxf(v, __shfl_xor(v, 1)); v = fmaxf(v, __shfl_xor(v, 2)); v = fmaxf(v, __shfl_xor(v, 4)); v = fmaxf(v, __shfl_xor(v, 8)); return v; }
#define MFMA16(a, b, c) __builtin_amdgcn_mfma_f32_16x16x32_bf16((a), (b), (c), 0, 0, 0)
#define LDS_WAIT() asm volatile("s_waitcnt lgkmcnt(0)" ::: "memory")

template <int MODE> struct Epi {
    static constexpr bool PERM = true, AFTER_DRAIN = false;
    bf16_t* O; float* Gout; const float* lbv; int ldc;
    __device__ __forceinline__ void operator()(const f32x4 (&acc)[2][2][4][2], const pg8::Unit& u, int wr, int wc, int fr, int fq) const {
        const int row0 = u.pm * 256 + wr * 64 + fr;
        const int pn = u.pn;
#pragma unroll
        for (int ai = 0; ai < 2; ++ai)
#pragma unroll
            for (int m = 0; m < 4; ++m) {
                const size_t row = (size_t)(row0 + ai * 128 + m * 16);
                if (MODE == 3) {
                    const int col = pn * 128 + wc * 32 + fq * 8;
                    const f32x4 g0 = acc[ai][0][m][0], g1 = acc[ai][0][m][1], u0 = acc[ai][1][m][0], u1 = acc[ai][1][m][1];
                    u32x4 w;
                    w.x = pk2(silu_f(g0[0]) * u0[0], silu_f(g0[1]) * u0[1]); w.y = pk2(silu_f(g0[2]) * u0[2], silu_f(g0[3]) * u0[3]);
                    w.z = pk2(silu_f(g1[0]) * u1[0], silu_f(g1[1]) * u1[1]); w.w = pk2(silu_f(g1[2]) * u1[2], silu_f(g1[3]) * u1[3]);
                    *(u32x4*)(O + row * ldc + col) = w;
                } else {
#pragma unroll
                    for (int bj = 0; bj < 2; ++bj) {
                        const int c0 = pn * 256 + bj * 128 + wc * 32 + fq * 8;
                        f32x4 v0 = acc[ai][bj][m][0], v1 = acc[ai][bj][m][1];
                        if (MODE == 2) {
                            u32x4 w; w.x = pk2(v0[0], v0[1]); w.y = pk2(v0[2], v0[3]); w.z = pk2(v1[0], v1[1]); w.w = pk2(v1[2], v1[3]);
                            *(u32x4*)(O + row * ldc + c0) = w;
                        } else {
                            if (pn >= 8 && pn < 12) {
                                const int gc = c0 - 2048;
                                const f32x4 l0 = *(const f32x4*)(lbv + gc), l1 = *(const f32x4*)(lbv + gc + 4);
                                f32x4 o0, o1;
#pragma unroll
                                for (int e = 0; e < 4; ++e) {
                                    o0[e] = __logf(l0[e] + (1.f - l0[e]) / (1.f + __expf(-v0[e])));
                                    o1[e] = __logf(l1[e] + (1.f - l1[e]) / (1.f + __expf(-v1[e])));
                                }
                                *(f32x4*)(Gout + row * 1024 + gc) = o0; *(f32x4*)(Gout + row * 1024 + gc + 4) = o1;
                            } else {
                                if (pn < 2) { v0 = v0 * 0.125f; v1 = v1 * 0.125f; }
                                if (pn == 6 || pn == 7 || pn >= 14) {
#pragma unroll
                                    for (int e = 0; e < 4; ++e) { v0[e] = silu_f(v0[e]); v1[e] = silu_f(v1[e]); }
                                }
                                const int col = pn >= 12 ? c0 - 1024 : c0;
                                u32x4 w; w.x = pk2(v0[0], v0[1]); w.y = pk2(v0[2], v0[3]); w.z = pk2(v1[0], v1[1]); w.w = pk2(v1[2], v1[3]);
                                *(u32x4*)(O + row * PBP + col) = w;
                            }
                        }
                    }
                }
            }
    }
};

struct Sched1 {
    pg8::StaticOrder so;
    __device__ bool next(int i, pg8::Unit& u) const {
        const long L = (long)i * so.G + so.c;
        if (L < 1024) return so.next(i, u);
        const int e = (int)(L - 1024); if (e >= 20) return false;
        const int t = e % 10; u.pm = 64 + e / 10; u.pn = t < 4 ? 2 + t : 4 + t;
        return true;
    }
    __device__ __forceinline__ void a_ready(const pg8::Unit&) const {}
    __device__ __forceinline__ void done(const pg8::Unit&) const {}
};

__device__ __forceinline__ void transpose_tile(const float* W, int N, bf16_t* WT, int K, int k0, int n0, int drow0, LAS unsigned char* lds, int tid) {
    LAS bf16_t* tl = (LAS bf16_t*)lds;
    const int kr = tid >> 4, nc = (tid & 15) * 4;
#pragma unroll
    for (int h = 0; h < 2; ++h) {
        const int k = kr + 32 * h;
        const f32x4 v = *(const f32x4*)(W + (size_t)(k0 + k) * N + n0 + nc);
        tl[(nc + 0) * 72 + k] = (bf16_t)f2bf(v[0]); tl[(nc + 1) * 72 + k] = (bf16_t)f2bf(v[1]);
        tl[(nc + 2) * 72 + k] = (bf16_t)f2bf(v[2]); tl[(nc + 3) * 72 + k] = (bf16_t)f2bf(v[3]);
    }
    __syncthreads();
    const int n = tid >> 3, kc = (tid & 7) * 8;
    const u32x4 o = *(const LAS u32x4*)(tl + n * 72 + kc);
    *(u32x4*)(WT + (size_t)(drow0 + n) * K + k0 + kc) = o;
    __syncthreads();
}

__device__ __forceinline__ void p0_prologue(const Params& p, LAS unsigned char* lds, int bid, int G, int tid) {
    unsigned char* ws = p.ws;
    float* mod = (float*)(ws + WS_MOD);
    if (bid == G - 1) {
        const float* lbl = p.in[12]; float* lbv = (float*)(ws + WS_LB);
        for (int c = tid; c < 1024; c += NTHREADS) lbv[c] = 1.f / (1.f + expf(lbl[1024 + c] - lbl[c]));
    }
    for (int j = bid; j < 192; j += G) {
        const float* w_ada = p.in[4]; const float* cvec = p.in[1]; const float* cctx = p.in[3];
        const int n0 = j * 32, rl = tid >> 3, cl = (tid & 7) * 4;
        f32x4 a0 = {0.f, 0.f, 0.f, 0.f}, a1 = a0, a2 = a0;
#pragma unroll 8
        for (int pp = 0; pp < 16; ++pp) {
            const int k = pp * 64 + rl;
            const f32x4 w = *(const f32x4*)(w_ada + (size_t)k * 6144 + n0 + cl);
            const float s0 = silu_f(cvec[k]), s1 = silu_f(cvec[1024 + k]), s2 = silu_f(cctx[k]);
            a0 += w * s0; a1 += w * s1; a2 += w * s2;
        }
        LAS float* red = (LAS float*)lds;
        *(LAS f32x4*)(red + (rl * 3 + 0) * 32 + cl) = a0; *(LAS f32x4*)(red + (rl * 3 + 1) * 32 + cl) = a1; *(LAS f32x4*)(red + (rl * 3 + 2) * 32 + cl) = a2;
        __syncthreads();
        if (tid < 96) {
            const int r = tid >> 5, n = tid & 31; float s = p.in[5][n0 + n];
            for (int q = 0; q < 64; ++q) s += red[(q * 3 + r) * 32 + n];
            mod[r * 6144 + n0 + n] = s;
        }
        __syncthreads();
    }
    constexpr int I1 = 16 * 64, I2 = 16 * 16, I3 = 16 * 88, I4 = 44 * 16;
    for (int it = bid; it < I1 + I2 + I3 + I4; it += G) {
        int r = it;
        if (r < I1) { const int kt = r / 64, nt = r % 64; transpose_tile(p.in[10], NIN, (bf16_t*)(ws + WS_WT1), D, kt * 64, nt * 64, nt * 64, lds, tid); continue; } r -= I1;
        if (r < I2) { const int kt = r / 16, nt = r % 16; transpose_tile(p.in[14], D, (bf16_t*)(ws + WS_WT2), D, kt * 64, nt * 64, nt * 64, lds, tid); continue; } r -= I2;
        if (r < I3) { const int kt = r / 88, nt = r % 88; const int n0 = nt * 64; int drow;
            if (n0 < DFF) drow = (n0 / 128) * 256 + (n0 % 128); else { const int mm = n0 - DFF; drow = (mm / 128) * 256 + 128 + (mm % 128); }
            transpose_tile(p.in[15], NFF2, (bf16_t*)(ws + WS_WT3), D, kt * 64, n0, drow, lds, tid); continue; } r -= I3;
        { const int kt = r / 16, nt = r % 16; transpose_tile(p.in[16], D, (bf16_t*)(ws + WS_WT4), DFF, kt * 64, nt * 64, nt * 64, lds, tid); }
    }
}

__device__ __forceinline__ void p1_rows(const Params& p, int bid, int G, int tid) {
    const int lane = tid & 63, wave = tid >> 6;
    const float* mod = (const float*)(p.ws + WS_MOD); const float* npre = p.in[6];
    bf16_t* Hn = (bf16_t*)(p.ws + WS_HN);
    for (int m = bid * 8 + wave; m < MTOT; m += G * 8) {
        const float* src; int mr;
        if (m < MROWS) { src = p.in[0] + (size_t)m * D; mr = m >> 13; } else { src = p.in[2] + (size_t)(m - MROWS) * D; mr = 2; }
        f32x4 v[4]; float ss = 0.f;
#pragma unroll
        for (int j = 0; j < 4; ++j) { v[j] = ((const f32x4*)src)[lane + 64 * j]; ss += (v[j][0] * v[j][0] + v[j][1] * v[j][1]) + (v[j][2] * v[j][2] + v[j][3] * v[j][3]); }
        ss = wave_sum(ss);
        const float rinv = rsqrtf(ss * (1.f / D) + EPS);
        const float* mrow = mod + mr * 6144;
#pragma unroll
        for (int j = 0; j < 4; ++j) {
            const int col = (lane + 64 * j) * 4;
            const f32x4 w = *(const f32x4*)(npre + col), sc = *(const f32x4*)(mrow + 1024 + col), sh = *(const f32x4*)(mrow + col);
            const f32x4 h = v[j] * rinv * w * (sc + 1.f) + sh;
            u32x2 o; o.x = pk2(h[0], h[1]); o.y = pk2(h[2], h[3]);
            *(u32x2*)(Hn + (size_t)m * D + col) = o;
        }
    }
}

__device__ __forceinline__ void p7_rows(const Params& p, int bid, int G, int tid) {
    const int lane = tid & 63, wave = tid >> 6;
    const float* mod = (const float*)(p.ws + WS_MOD); const float* npost = p.in[7]; const float* nfpre = p.in[8];
    const bf16_t* Y2 = (const bf16_t*)(p.ws + WS_PB); bf16_t* Hn = (bf16_t*)(p.ws + WS_HN);
    for (int m = bid * 8 + wave; m < MROWS; m += G * 8) {
        const float* mrow = mod + (m >> 13) * 6144;
        f32x4 y[4], xv[4]; float ss = 0.f;
#pragma unroll
        for (int j = 0; j < 4; ++j) {
            const int col = (lane + 64 * j) * 4;
            const u32x2 yy = *(const u32x2*)(Y2 + (size_t)m * D + col);
            y[j][0] = bf2f(yy.x & 0xffffu); y[j][1] = bf2f(yy.x >> 16); y[j][2] = bf2f(yy.y & 0xffffu); y[j][3] = bf2f(yy.y >> 16);
            xv[j] = *(const f32x4*)(p.in[0] + (size_t)m * D + col);
            ss += (y[j][0] * y[j][0] + y[j][1] * y[j][1]) + (y[j][2] * y[j][2] + y[j][3] * y[j][3]);
        }
        ss = wave_sum(ss);
        const float rinv = rsqrtf(ss * (1.f / D) + EPS);
        float s1 = 0.f;
#pragma unroll
        for (int j = 0; j < 4; ++j) {
            const int col = (lane + 64 * j) * 4;
            const f32x4 w = *(const f32x4*)(npost + col), gt = *(const f32x4*)(mrow + 2048 + col);
            xv[j] = xv[j] + gt * (y[j] * rinv * w);
            *(f32x4*)(p.out + (size_t)m * D + col) = xv[j];
            s1 += (xv[j][0] * xv[j][0] + xv[j][1] * xv[j][1]) + (xv[j][2] * xv[j][2] + xv[j][3] * xv[j][3]);
        }
        s1 = wave_sum(s1);
        const float r1 = rsqrtf(s1 * (1.f / D) + EPS);
#pragma unroll
        for (int j = 0; j < 4; ++j) {
            const int col = (lane + 64 * j) * 4;
            const f32x4 w = *(const f32x4*)(nfpre + col), sc = *(const f32x4*)(mrow + 4096 + col), sh = *(const f32x4*)(mrow + 3072 + col);
            const f32x4 h = xv[j] * r1 * w * (sc + 1.f) + sh;
            u32x2 o; o.x = pk2(h[0], h[1]); o.y = pk2(h[2], h[3]);
            *(u32x2*)(Hn + (size_t)m * D + col) = o;
        }
    }
}

__device__ __forceinline__ void p10_rows(const Params& p, int bid, int G, int tid) {
    const int lane = tid & 63, wave = tid >> 6;
    const float* mod = (const float*)(p.ws + WS_MOD); const float* nfpost = p.in[9];
    const bf16_t* FF = (const bf16_t*)(p.ws + WS_G);
    for (int m = bid * 8 + wave; m < MROWS; m += G * 8) {
        const float* mrow = mod + (m >> 13) * 6144;
        f32x4 y[4]; float ss = 0.f;
#pragma unroll
        for (int j = 0; j < 4; ++j) {
            const int col = (lane + 64 * j) * 4;
            const u32x2 yy = *(const u32x2*)(FF + (size_t)m * D + col);
            y[j][0] = bf2f(yy.x & 0xffffu); y[j][1] = bf2f(yy.x >> 16); y[j][2] = bf2f(yy.y & 0xffffu); y[j][3] = bf2f(yy.y >> 16);
            ss += (y[j][0] * y[j][0] + y[j][1] * y[j][1]) + (y[j][2] * y[j][2] + y[j][3] * y[j][3]);
        }
        ss = wave_sum(ss);
        const float rinv = rsqrtf(ss * (1.f / D) + EPS);
#pragma unroll
        for (int j = 0; j < 4; ++j) {
            const int col = (lane + 64 * j) * 4;
            const f32x4 w = *(const f32x4*)(nfpost + col), gt = *(const f32x4*)(mrow + 5120 + col);
            const f32x4 x1 = *(const f32x4*)(p.out + (size_t)m * D + col);
            *(f32x4*)(p.out + (size_t)m * D + col) = x1 + gt * (y[j] * rinv * w);
        }
    }
}

__device__ __forceinline__ void na_phase(const Params& p, LAS unsigned char* lds, int bid, int G, int tid) {
    const bf16_t* PB = (const bf16_t*)(p.ws + WS_PB); const float* rpb = p.in[11]; bf16_t* Ycat = (bf16_t*)(p.ws + WS_HN);
    const int lane = tid & 63, wave = __builtin_amdgcn_readfirstlane(tid >> 6), hl = wave >> 2, qg = wave & 3, l15 = lane & 15, quad = lane >> 4;
    LAS unsigned char* sK = lds;
    LAS unsigned char* sV = lds + 18432;
    LAS unsigned char* sP = lds + 36864 + wave * 2304;
    LAS float* sR = (LAS float*)(lds + 55296);
    for (int it = bid; it < 1024; it += G) {
        const int b = it >> 9, r = (it >> 2) & 127, hp = it & 3;
        const int head = hp * 2 + hl;
        const int r0 = min(max(r - 4, 0), 120);
        __syncthreads();
        for (int i = tid; i < 930; i += NTHREADS) sR[(i / 465) * 480 + (i % 465)] = rpb[hp * 930 + i];
        const size_t qrow = (size_t)b * T + r * 64 + qg * 16 + l15;
        bf16x8 aq[2];
#pragma unroll
        for (int ks = 0; ks < 2; ++ks) aq[ks] = *(const bf16x8*)(PB + qrow * PBP + head * 64 + ks * 32 + quad * 8);
        f32x4 o[4]; float mrow[4], lrow[4];
#pragma unroll
        for (int i = 0; i < 4; ++i) { o[i] = (f32x4){0.f, 0.f, 0.f, 0.f}; mrow[i] = -1e30f; lrow[i] = 0.f; }
        for (int kb = 0; kb < 12; ++kb) {
            const size_t krow0 = (kb < 4) ? (size_t)MROWS + b * LC + kb * 64 : (size_t)b * T + (size_t)(r0 + kb - 4) * 64;
            __syncthreads();
#pragma unroll
            for (int h2 = 0; h2 < 2; ++h2) {
                const int idx = tid + 512 * h2, hh = idx >> 9, key = (idx >> 3) & 63, ch = idx & 7;
                const bf16_t* src = PB + (krow0 + key) * PBP + (hp * 2 + hh) * 64 + ch * 8;
                const u32x4 kv = *(const u32x4*)(src + 512);
                const u32x4 vv = *(const u32x4*)(src + 1024);
                *(LAS u32x4*)(sK + hh * 9216 + key * 144 + ch * 16) = kv;
                LAS bf16_t* vt = (LAS bf16_t*)(sV + hh * 9216);
                const int kphys = (((key >> 3) ^ ch) << 3) | (key & 7);
#pragma unroll
                for (int e = 0; e < 4; ++e) {
                    vt[(ch * 8 + 2 * e) * 72 + kphys] = (bf16_t)(vv[e] & 0xffffu);
                    vt[(ch * 8 + 2 * e + 1) * 72 + kphys] = (bf16_t)(vv[e] >> 16);
                }
            }
            __syncthreads();
            f32x4 s[4];
#pragma unroll
            for (int nt = 0; nt < 4; ++nt) {
                s[nt] = (f32x4){0.f, 0.f, 0.f, 0.f};
#pragma unroll
                for (int ks = 0; ks < 2; ++ks) {
                    const bf16x8 bk = *(const LAS bf16x8*)(sK + hl * 9216 + (nt * 16 + l15) * 144 + ks * 64 + quad * 16);
                    s[nt] = MFMA16(aq[ks], bk, s[nt]);
                }
            }
            if (kb >= 4) {
                const int dr = r0 + (kb - 4) - r + 7;
#pragma unroll
                for (int nt = 0; nt < 4; ++nt)
#pragma unroll
                    for (int j = 0; j < 4; ++j) {
                        const int cq = qg * 16 + quad * 4 + j, kc = nt * 16 + l15;
                        const int c0 = min(max(cq - 8, 0), 48);
                        const bool valid = (kc >= c0) && (kc <= c0 + 15);
                        const int dc = min(max(kc - cq + 15, 0), 30);
                        const float bias = sR[hl * 480 + dr * 31 + dc];
                        s[nt][j] = valid ? s[nt][j] + bias : -1e30f;
                    }
            }
#pragma unroll
            for (int j = 0; j < 4; ++j) {
                float mx = fmaxf(fmaxf(s[0][j], s[1][j]), fmaxf(s[2][j], s[3][j]));
                mx = max16(mx);
                const float mnew = fmaxf(mrow[j], mx);
                const float alpha = __expf(mrow[j] - mnew);
                mrow[j] = mnew;
                float rs = 0.f;
#pragma unroll
                for (int nt = 0; nt < 4; ++nt) { const float pv = __expf(s[nt][j] - mnew); s[nt][j] = pv; rs += pv; }
                rs = sum16(rs);
                lrow[j] = lrow[j] * alpha + rs;
#pragma unroll
                for (int nt = 0; nt < 4; ++nt) o[nt][j] *= alpha;
            }
#pragma unroll
            for (int nt = 0; nt < 4; ++nt)
#pragma unroll
                for (int j = 0; j < 4; ++j) ((LAS bf16_t*)sP)[(quad * 4 + j) * 72 + nt * 16 + l15] = (bf16_t)f2bf(s[nt][j]);
            LDS_WAIT();
            bf16x8 ap[2];
#pragma unroll
            for (int ks = 0; ks < 2; ++ks) ap[ks] = *(const LAS bf16x8*)(sP + l15 * 144 + ks * 64 + quad * 16);
#pragma unroll
            for (int nt = 0; nt < 4; ++nt) {
                const int d = nt * 16 + l15;
#pragma unroll
                for (int ks = 0; ks < 2; ++ks) {
                    const int phys = (ks * 4 + quad) ^ ((d >> 3) & 7);
                    const bf16x8 bv = *(const LAS bf16x8*)(sV + hl * 9216 + d * 144 + phys * 16);
                    o[nt] = MFMA16(ap[ks], bv, o[nt]);
                }
            }
        }
#pragma unroll
        for (int j = 0; j < 4; ++j) {
            const float inv = 1.f / lrow[j];
            const size_t tok = (size_t)b * T + r * 64 + qg * 16 + quad * 4 + j;
#pragma unroll
            for (int nt = 0; nt < 4; ++nt) Ycat[tok * 1024 + head * 64 + nt * 16 + l15] = (bf16_t)f2bf(o[nt][j] * inv);
        }
    }
}

__device__ __forceinline__ void v_tile_to_lds(const bf16_t* PB, size_t row0, int h, LAS unsigned char* sVT, int tid) {
    LAS bf16_t* vt = (LAS bf16_t*)sVT;
#pragma unroll
    for (int h2 = 0; h2 < 2; ++h2) {
        const int idx = tid + 512 * h2, s = idx >> 4, ch = idx & 15;
        const u32x4 vv = *(const u32x4*)(PB + (row0 + s) * PBP + 2048 + h * 128 + ch * 8);
        const int sphys = (((s >> 3) ^ (ch & 7)) << 3) | (s & 7);
#pragma unroll
        for (int e = 0; e < 4; ++e) {
            vt[(ch * 8 + 2 * e) * 72 + sphys] = (bf16_t)(vv[e] & 0xffffu);
            vt[(ch * 8 + 2 * e + 1) * 72 + sphys] = (bf16_t)(vv[e] >> 16);
        }
    }
}

__device__ __forceinline__ void gla_a1(const Params& p, LAS unsigned char* lds, int bid, int G, int tid) {
    const bf16_t* PB = (const bf16_t*)(p.ws + WS_PB); const float* Gb = (const float*)(p.ws + WS_G);
    float* dec = (float*)(p.ws + WS_DEC);
    const int lane = tid & 63, wave = __builtin_amdgcn_readfirstlane(tid >> 6), l15 = lane & 15, quad = lane >> 4;
    LAS unsigned char* sKh = lds;
    LAS unsigned char* sVT = lds + 18432;
    LAS float* sTot = (LAS float*)(lds + 36864);
    const int k = tid & 127, sq = tid >> 7;
    for (int id = bid; id < N_ITEMS; id += G) {
        int chain; size_t row0; bf16_t* slot;
        if (id < N_LAT_ITEMS) { chain = id >> 7; row0 = (size_t)(chain >> 3) * T + (size_t)(id & 127) * 64; slot = (bf16_t*)((unsigned char*)p.out + (size_t)id * 32768); }
        else { const int e = id - N_LAT_ITEMS; chain = e >> 2; row0 = (size_t)MROWS + (size_t)(chain >> 3) * LC + (size_t)(e & 3) * 64; slot = (bf16_t*)(p.ws + WS_UCTX + (size_t)e * 32768); }
        const int h = (chain >> 1) & 3, dir = chain & 1;
        const float* gp = Gb + (row0 + sq * 16) * 1024 + dir * 512 + h * 128 + k;
        float g[16], pre[16];
#pragma unroll
        for (int i = 0; i < 16; ++i) g[i] = gp[(size_t)i * 1024];
        float run = 0.f;
        if (dir == 0) {
#pragma unroll
            for (int i = 0; i < 16; ++i) { run += g[i]; pre[i] = run; }
        } else {
#pragma unroll
            for (int i = 15; i >= 0; --i) { run += g[i]; pre[i] = run; }
        }
        sTot[sq * 128 + k] = run;
        v_tile_to_lds(PB, row0, h, sVT, tid);
        __syncthreads();
        const float t0 = sTot[k], t1 = sTot[128 + k], t2 = sTot[256 + k], t3 = sTot[384 + k];
        const float total = (t0 + t1) + (t2 + t3);
        float off;
        if (dir == 0) off = (sq > 0 ? t0 : 0.f) + (sq > 1 ? t1 : 0.f) + (sq > 2 ? t2 : 0.f);
        else off = (sq < 1 ? t1 : 0.f) + (sq < 2 ? t2 : 0.f) + (sq < 3 ? t3 : 0.f);
        u32x4 w0, w1;
        {
            float kh[16];
#pragma unroll
            for (int i = 0; i < 16; ++i) kh[i] = (1.f - __expf(g[i])) * __expf(total - off - pre[i]);
            w0.x = pk2(kh[0], kh[1]); w0.y = pk2(kh[2], kh[3]); w0.z = pk2(kh[4], kh[5]); w0.w = pk2(kh[6], kh[7]);
            w1.x = pk2(kh[8], kh[9]); w1.y = pk2(kh[10], kh[11]); w1.z = pk2(kh[12], kh[13]); w1.w = pk2(kh[14], kh[15]);
        }
        *(LAS u32x4*)(sKh + k * 144 + sq * 32) = w0; *(LAS u32x4*)(sKh + k * 144 + sq * 32 + 16) = w1;
        if (sq == 0) dec[(size_t)id * 128 + k] = __expf(total);
        __syncthreads();
        f32x4 acc[8];
#pragma unroll
        for (int nt = 0; nt < 8; ++nt) acc[nt] = (f32x4){0.f, 0.f, 0.f, 0.f};
        bf16x8 a[2];
        {
            const int v = wave * 16 + l15;
#pragma unroll
            for (int ks = 0; ks < 2; ++ks) { const int phys = (ks * 4 + quad) ^ ((v >> 3) & 7); a[ks] = *(const LAS bf16x8*)(sVT + v * 144 + phys * 16); }
        }
#pragma unroll
        for (int nt = 0; nt < 8; ++nt)
#pragma unroll
            for (int ks = 0; ks < 2; ++ks) {
                const bf16x8 bb = *(const LAS bf16x8*)(sKh + (nt * 16 + l15) * 144 + ks * 64 + quad * 16);
                acc[nt] = MFMA16(a[ks], bb, acc[nt]);
            }
#pragma unroll
        for (int nt = 0; nt < 8; ++nt)
#pragma unroll
            for (int j = 0; j < 4; ++j) slot[(wave * 16 + quad * 4 + j) * 128 + nt * 16 + l15] = (bf16_t)f2bf(acc[nt][j]);
        __syncthreads();
    }
}

template <bool DUMMY> __device__ __forceinline__ void gla_scan(const Params& p, int bid, int G, int tid) {
    const float* dec = (const float*)(p.ws + WS_DEC);
    for (int gt = bid * NTHREADS + tid; gt < 16 * 8192; gt += G * NTHREADS) {
        const int chain = gt >> 13, e = gt & 8191, dir = chain & 1, kk = (2 * e) & 127;
        float s0 = 0.f, s1 = 0.f;
#pragma unroll
        for (int j = 0; j < 4; ++j) {
            const int idc = chain * 4 + (dir ? 3 - j : j);
            const unsigned u = *(const unsigned*)(p.ws + WS_UCTX + (size_t)idc * 32768 + (size_t)e * 4);
            const f32x2 d = *(const f32x2*)(dec + (size_t)(N_LAT_ITEMS + idc) * 128 + kk);
            s0 = d.x * s0 + bf2f(u & 0xffffu); s1 = d.y * s1 + bf2f(u >> 16);
        }
        unsigned char* base = (unsigned char*)p.out + (size_t)chain * 128 * 32768 + (size_t)e * 4;
        const float* dbase = dec + (size_t)chain * 128 * 128 + kk;
        for (int jb = 0; jb < 16; ++jb) {
            unsigned u[8]; f32x2 d[8];
#pragma unroll
            for (int i = 0; i < 8; ++i) {
                const int j = jb * 8 + i, c = dir ? 127 - j : j;
                u[i] = *(const unsigned*)(base + (size_t)c * 32768);
                d[i] = *(const f32x2*)(dbase + (size_t)c * 128);
            }
#pragma unroll
            for (int i = 0; i < 8; ++i) {
                const int j = jb * 8 + i, c = dir ? 127 - j : j;
                *(unsigned*)(base + (size_t)c * 32768) = DUMMY ? u[i] : pk2(s0, s1);
                s0 = d[i].x * s0 + bf2f(u[i] & 0xffffu); s1 = d[i].y * s1 + bf2f(u[i] >> 16);
            }
        }
    }
}

__device__ __forceinline__ void gla_a3(const Params& p, LAS unsigned char* lds, int bid, int G, int tid) {
    const bf16_t* PB = (const bf16_t*)(p.ws + WS_PB); const float* Gb = (const float*)(p.ws + WS_G);
    const float* hgw = p.in[13]; bf16_t* Ycat = (bf16_t*)(p.ws + WS_HN);
    const int lane = tid & 63, wave = __builtin_amdgcn_readfirstlane(tid >> 6), l15 = lane & 15, quad = lane >> 4;
    const int mt = wave & 3, nh = wave >> 2;
    LAS unsigned char* sQh = lds;
    LAS unsigned char* sQt = lds + 17408;
    LAS unsigned char* sKt = lds + 34816;
    LAS unsigned char* sVT = lds + 52224;
    LAS unsigned char* sP = lds + 70656 + wave * 2304;
    LAS float* sTot = (LAS float*)(lds + 89088);
    LAS float* sSS = (LAS float*)(lds + 91136);
    const int k = tid & 127, sq = tid >> 7;
    for (int it = bid; it < 1024; it += G) {
        const int b = it >> 9, h = (it >> 7) & 3, c = it & 127;
        const size_t row0 = (size_t)b * T + (size_t)c * 64;
        __syncthreads();
        v_tile_to_lds(PB, row0, h, sVT, tid);
        f32x4 acc[4];
#pragma unroll
        for (int nt = 0; nt < 4; ++nt) acc[nt] = (f32x4){0.f, 0.f, 0.f, 0.f};
#pragma unroll 1
        for (int dir = 0; dir < 2; ++dir) {
            if (dir) __syncthreads();
            const float* gp = Gb + (row0 + sq * 16) * 1024 + dir * 512 + h * 128 + k;
            float g[16], pre[16];
#pragma unroll
            for (int i = 0; i < 16; ++i) g[i] = gp[(size_t)i * 1024];
            float run = 0.f;
            if (dir == 0) {
#pragma unroll
                for (int i = 0; i < 16; ++i) { run += g[i]; pre[i] = run; }
            } else {
#pragma unroll
                for (int i = 15; i >= 0; --i) { run += g[i]; pre[i] = run; }
            }
            sTot[sq * 128 + k] = run;
            __syncthreads();
            const float t0 = sTot[k], t1 = sTot[128 + k], t2 = sTot[256 + k], t3 = sTot[384 + k];
            const float total = (t0 + t1) + (t2 + t3);
            float off;
            if (dir == 0) off = (sq > 0 ? t0 : 0.f) + (sq > 1 ? t1 : 0.f) + (sq > 2 ? t2 : 0.f);
            else off = (sq < 1 ? t1 : 0.f) + (sq < 2 ? t2 : 0.f) + (sq < 3 ? t3 : 0.f);
            const float rr = 0.5f * total;
            const bf16_t* qp = PB + (row0 + sq * 16) * PBP + 1536 + h * 128 + k;
#pragma unroll
            for (int i = 0; i < 16; ++i) {
                const int s = sq * 16 + i;
                const float bs = off + pre[i];
                const float qv = bf2f((unsigned)qp[(size_t)i * PBP]);
                const float qh = qv * __expf(bs), qt = qv * exp_c(bs - rr), kt = (1.f - __expf(g[i])) * exp_c(rr - bs);
                ((LAS bf16_t*)sQh)[s * 136 + k] = (bf16_t)f2bf(qh);
                ((LAS bf16_t*)sQt)[s * 136 + k] = (bf16_t)f2bf(qt);
                ((LAS bf16_t*)sKt)[s * 136 + k] = (bf16_t)f2bf(kt);
            }
            __syncthreads();
            const bf16_t* Sp = (const bf16_t*)((const unsigned char*)p.out + (size_t)((((b * 4 + h) * 2 + dir) * 128) + c) * 32768);
#pragma unroll
            for (int ks = 0; ks < 4; ++ks) {
                const bf16x8 a = *(const LAS bf16x8*)(sQh + (mt * 16 + l15) * 272 + ks * 64 + quad * 16);
#pragma unroll
                for (int nt = 0; nt < 4; ++nt) {
                    const int v = nh * 64 + nt * 16 + l15;
                    const bf16x8 bs_ = *(const bf16x8*)(Sp + v * 128 + ks * 32 + quad * 8);
                    acc[nt] = MFMA16(a, bs_, acc[nt]);
                }
            }
            f32x4 at[4];
#pragma unroll
            for (int st = 0; st < 4; ++st) at[st] = (f32x4){0.f, 0.f, 0.f, 0.f};
#pragma unroll
            for (int ks = 0; ks < 4; ++ks) {
                const bf16x8 a = *(const LAS bf16x8*)(sQt + (mt * 16 + l15) * 272 + ks * 64 + quad * 16);
#pragma unroll
                for (int st = 0; st < 4; ++st) {
                    const bf16x8 bk = *(const LAS bf16x8*)(sKt + (st * 16 + l15) * 272 + ks * 64 + quad * 16);
                    at[st] = MFMA16(a, bk, at[st]);
                }
            }
#pragma unroll
            for (int st = 0; st < 4; ++st)
#pragma unroll
                for (int j = 0; j < 4; ++j) {
                    const int i_ = mt * 16 + quad * 4 + j, s_ = st * 16 + l15;
                    const bool keep = dir ? (s_ >= i_) : (s_ <= i_);
                    ((LAS bf16_t*)sP)[(quad * 4 + j) * 72 + s_] = (bf16_t)f2bf(keep ? at[st][j] : 0.f);
                }
            LDS_WAIT();
            bf16x8 ap[2];
#pragma unroll
            for (int ks = 0; ks < 2; ++ks) ap[ks] = *(const LAS bf16x8*)(sP + l15 * 144 + ks * 64 + quad * 16);
#pragma unroll
            for (int nt = 0; nt < 4; ++nt) {
                const int v = nh * 64 + nt * 16 + l15;
#pragma unroll
                for (int ks = 0; ks < 2; ++ks) {
                    const int phys = (ks * 4 + quad) ^ ((v >> 3) & 7);
                    const bf16x8 bv = *(const LAS bf16x8*)(sVT + v * 144 + phys * 16);
                    acc[nt] = MFMA16(ap[ks], bv, acc[nt]);
                }
            }
        }
#pragma unroll
        for (int j = 0; j < 4; ++j) {
            float ss = (acc[0][j] * acc[0][j] + acc[1][j] * acc[1][j]) + (acc[2][j] * acc[2][j] + acc[3][j] * acc[3][j]);
            ss = sum16(ss);
            if (l15 == 0) sSS[nh * 64 + mt * 16 + quad * 4 + j] = ss;
        }
        __syncthreads();
#pragma unroll
        for (int j = 0; j < 4; ++j) {
            const int i_ = mt * 16 + quad * 4 + j;
            const float tot = sSS[i_] + sSS[64 + i_];
            const float rinv = rsqrtf(tot * (1.f / 128.f) + EPS);
#pragma unroll
            for (int nt = 0; nt < 4; ++nt) {
                const int v = nh * 64 + nt * 16 + l15;
                const float gate = bf2f((unsigned)PB[(row0 + i_) * PBP + 2560 + h * 128 + v]);
                Ycat[(row0 + i_) * 1024 + 512 + h * 128 + v] = (bf16_t)f2bf(acc[nt][j] * rinv * hgw[v] * gate);
            }
        }
    }
}

#define XB_TMO      128
#define XB_XCNT(j)  (256  + 64 * (j))
#define XB_XSUB(j)  (1280 + 64 * (j))
#define XB_XGEN(j)  (2304 + 64 * (j))
#define XB_TOP      3328
#define XB_TOPGEN   3392
#define XCD_BAR_WORDS 3456
#define XB_SPIN_CAP (1u << 18)

__device__ __forceinline__ unsigned xb_ld(unsigned* p)              { return __hip_atomic_load(p, __ATOMIC_RELAXED, __HIP_MEMORY_SCOPE_AGENT); }
__device__ __forceinline__ unsigned xb_add(unsigned* p, unsigned v) { return __hip_atomic_fetch_add(p, v, __ATOMIC_RELAXED, __HIP_MEMORY_SCOPE_AGENT); }
__device__ __forceinline__ unsigned xb_xcc_id() { return (unsigned)__builtin_amdgcn_s_getreg((3 << 11) | 20) & 0xFu; }
#define XB_SPIN(cond, bar) do { unsigned _sp = 0; while (cond) { __builtin_amdgcn_s_sleep(1); \
    if ((++_sp & 255u) == 0u) { if (xb_ld(&(bar)[XB_TMO])) break; if (_sp > XB_SPIN_CAP) { atomicAdd(&(bar)[XB_TMO], 1u); break; } } } } while (0)

struct XcdBarrier {
    unsigned* bar; unsigned x;
    volatile LAS unsigned* st;
};

__device__ __forceinline__ XcdBarrier xcd_barrier_post(unsigned* bar, volatile LAS unsigned* st) {
    XcdBarrier b; b.bar = bar; b.x = xb_xcc_id(); b.st = st;
    if (threadIdx.x == 0) (void)xb_add(&bar[XB_XCNT(b.x)], 1u);
    return b;
}
__device__ __forceinline__ void xcd_barrier_complete(unsigned* bar, unsigned x, unsigned& nloc, unsigned& nx) {
    const unsigned G = gridDim.x * gridDim.y * gridDim.z;
    unsigned sum, cnt, mine, sp = 0u;
    for (;;) {
        sum = 0u; cnt = 0u; mine = 0u;
#pragma unroll
        for (unsigned j = 0; j < 16; ++j) { const unsigned c = xb_ld(&bar[XB_XCNT(j)]); sum += c; cnt += (c > 0u) ? 1u : 0u; mine = (j == x) ? c : mine; }
        if (sum == G) break;
        __builtin_amdgcn_s_sleep(1);
        if ((++sp & 255u) == 0u) { if (xb_ld(&bar[XB_TMO])) break; if (sp > XB_SPIN_CAP) { atomicAdd(&bar[XB_TMO], 1u); break; } }
    }
    nloc = mine > 0u ? mine : 1u; nx = cnt > 0u ? cnt : 1u;
}

__device__ __forceinline__ void xcd_barrier(const XcdBarrier& b) {
    asm volatile("s_waitcnt vmcnt(0)" ::: "memory");
    __syncthreads();
    if (threadIdx.x == 0) {
        unsigned* bar = b.bar;
        __builtin_amdgcn_s_waitcnt(0);
        unsigned nloc = b.st[0], nx = b.st[1];
        if (nloc == 0u) { xcd_barrier_complete(bar, b.x, nloc, nx); b.st[0] = nloc; b.st[1] = nx; }
        const unsigned old = xb_add(&bar[XB_XSUB(b.x)], 1u);
        const unsigned gen = old / nloc;
        if (old + 1u == (gen + 1u) * nloc) {
            __builtin_amdgcn_fence(__ATOMIC_RELEASE, "agent");
            asm volatile("s_waitcnt vmcnt(0)" ::: "memory");
            const unsigned og = xb_add(&bar[XB_TOP], 1u);
            const unsigned tg = og / nx;
            if (og + 1u == (tg + 1u) * nx) xb_add(&bar[XB_TOPGEN], 1u);
            else XB_SPIN(xb_ld(&bar[XB_TOPGEN]) == tg, bar);
            __builtin_amdgcn_fence(__ATOMIC_ACQUIRE, "agent");
            xb_add(&bar[XB_XGEN(b.x)], 1u);
            asm volatile("s_waitcnt vmcnt(0)" ::: "memory");
        } else {
            XB_SPIN(xb_ld(&bar[XB_XGEN(b.x)]) == gen, bar);
            __builtin_amdgcn_fence(__ATOMIC_ACQUIRE, "agent");
            asm volatile("s_waitcnt vmcnt(0)" ::: "memory");
        }
    }
    __syncthreads();
}

__global__ void __launch_bounds__(NTHREADS, 2) mega_fwd(Params p) {
    extern __shared__ __attribute__((aligned(16))) unsigned char lds_raw[];
    LAS unsigned char* lds = (LAS unsigned char*)lds_raw;
    cg::grid_group grid = cg::this_grid();
    const int tid = threadIdx.x, bid = blockIdx.x, G = gridDim.x;
    unsigned char* ws = p.ws;
#define IN(k) (p.ph_lo <= (k) && (k) < p.ph_hi)
    volatile LAS unsigned* MISC = (volatile LAS unsigned*)(lds + 131072);
    if (tid < 2) MISC[tid] = 0u;
    __syncthreads();
    XcdBarrier bar; bar.bar = (unsigned*)(ws + WS_CTL); bar.x = 0; bar.st = MISC;
    if (p.ph_hi - p.ph_lo > 1) bar = xcd_barrier_post((unsigned*)(ws + WS_CTL), MISC);
#define SEAM(k) do { if (IN(k) && IN((k) + 1)) { if ((k) == 0) grid.sync(); else xcd_barrier(bar); } } while (0)
#ifndef REP_P0
#define REP_P0 1
#define REP_NA 1
#define REP_A1 1
#define REP_A3 1
#endif
    if (IN(0)) { for (int rep = 0; rep < REP_P0; ++rep) { p0_prologue(p, lds, bid, G, tid); __syncthreads(); } }
    SEAM(0);
    if (IN(1)) p1_rows(p, bid, G, tid);
    SEAM(1);
    if (IN(2)) {
        pg8::Gemm g{(const bf16_t*)(ws + WS_HN), (const bf16_t*)(ws + WS_WT1), MTOT, NIN, D};
        Sched1 S; S.so.init(MROWS, NIN, G, bid);
        Epi<1> E{(bf16_t*)(ws + WS_PB), (float*)(ws + WS_G), (const float*)(ws + WS_LB), PBP};
        pg8::gemm_phase<Epi<1>, Sched1, true, true>(lds, g, S, E);
    }
    SEAM(2);
    if (IN(3)) { for (int rep = 0; rep < REP_NA; ++rep) { na_phase(p, lds, bid, G, tid); __syncthreads(); }
                 for (int rep = 0; rep < REP_A1; ++rep) { gla_a1(p, lds, bid, G, tid); __syncthreads(); } }
    SEAM(3);
#ifndef REP_SCAN
#define REP_SCAN 0
#define REP_SYNC 0
#endif
    if (IN(4)) { for (int rep = 0; rep < REP_SCAN; ++rep) gla_scan<true>(p, bid, G, tid);
                 for (int rep = 0; rep < REP_SYNC; ++rep) grid.sync();
                 gla_scan<false>(p, bid, G, tid); }
    SEAM(4);
    if (IN(5)) { for (int rep = 0; rep < REP_A3; ++rep) { gla_a3(p, lds, bid, G, tid); __syncthreads(); } }
    SEAM(5);
    if (IN(6)) {
        __syncthreads();
        pg8::Gemm g{(const bf16_t*)(ws + WS_HN), (const bf16_t*)(ws + WS_WT2), MROWS, D, D};
        pg8::StaticOrder S; S.init(MROWS, D, G, bid);
        Epi<2> E{(bf16_t*)(ws + WS_PB), nullptr, nullptr, D};
        pg8::gemm_phase<Epi<2>, pg8::StaticOrder, true, true>(lds, g, S, E);
    }
    SEAM(6);
    if (IN(7)) p7_rows(p, bid, G, tid);
    SEAM(7);
    if (IN(8)) {
        pg8::Gemm g{(const bf16_t*)(ws + WS_HN), (const bf16_t*)(ws + WS_WT3), MROWS, NFF2, D};
        pg8::StaticOrder S; S.init(MROWS, NFF2, G, bid);
        Epi<3> E{(bf16_t*)(ws + WS_PB), nullptr, nullptr, DFF};
        pg8::gemm_phase<Epi<3>, pg8::StaticOrder, true, true>(lds, g, S, E);
    }
    SEAM(8);
    if (IN(9)) {
        pg8::Gemm g{(const bf16_t*)(ws + WS_PB), (const bf16_t*)(ws + WS_WT4), MROWS, D, DFF};
        pg8::StaticOrder S; S.init(MROWS, D, G, bid);
        Epi<2> E{(bf16_t*)(ws + WS_G), nullptr, nullptr, D};
        pg8::gemm_phase<Epi<2>, pg8::StaticOrder, true, true>(lds, g, S, E);
    }
    SEAM(9);
    if (IN(10)) p10_rows(p, bid, G, tid);
#undef IN
#undef SEAM
}

#ifndef MK_PER_PHASE
#define MK_PER_PHASE 0
#endif
extern "C" void kernel_launch(void* const* d_in, const int* in_sizes, int n_in, void* d_out, int out_size, void* d_ws, size_t ws_size, hipStream_t stream) {
    static int grid = 0;
    if (grid == 0) {
        int dev = 0, cus = 0, per_cu = 0;
        (void)hipGetDevice(&dev);
        (void)hipDeviceGetAttribute(&cus, hipDeviceAttributeMultiprocessorCount, dev);
        if (hipFuncSetAttribute((const void*)mega_fwd, hipFuncAttributeMaxDynamicSharedMemorySize, LDS_BYTES) != hipSuccess) fprintf(stderr, "hipFuncSetAttribute failed\n");
        if (hipOccupancyMaxActiveBlocksPerMultiprocessor(&per_cu, (const void*)mega_fwd, NTHREADS, LDS_BYTES) != hipSuccess || per_cu < 1) { fprintf(stderr, "occupancy query: %d\n", per_cu); per_cu = 1; }
        (void)hipGetLastError();
        if (cus <= 0) cus = 256;
        grid = cus * 1;
        if (n_in != 17 || ws_size < WS_END) fprintf(stderr, "kernel_launch: unexpected n_in %d / ws %zu\n", n_in, ws_size);
    }
    (void)hipMemsetAsync((unsigned char*)d_ws + WS_CTL, 0, 16384, stream);
    Params p{};
    for (int i = 0; i < 17; ++i) p.in[i] = (const float*)d_in[i];
    p.out = (float*)d_out; p.ws = (unsigned char*)d_ws;
#if MK_PER_PHASE
    for (int ph = 0; ph < 11; ++ph) { p.ph_lo = ph; p.ph_hi = ph + 1; hipLaunchKernelGGL(mega_fwd, dim3(grid), dim3(NTHREADS), LDS_BYTES, stream, p); }
#else
    p.ph_lo = 0; p.ph_hi = 11;
    void* args[] = {&p};
    hipError_t e = hipLaunchCooperativeKernel((const void*)mega_fwd, dim3(grid), dim3(NTHREADS), args, LDS_BYTES, stream);
    if (e != hipSuccess) fprintf(stderr, "cooperative launch failed: %s (grid %d)\n", hipGetErrorString(e), grid);
#endif
}
```
